# Optimizing an MI355X kernel written in HIP

```python
import jax, jax.numpy as jnp
from jax import lax
import numpy as np

D_MODEL = 1024
BATCH = 8
SEQ = 4096
DEPTH = 4

N_MIXERS = 2
N_SSD_LAYERS = (DEPTH + 1) // 2
N_SB_LAYERS = DEPTH // 2
NORM_EPS = 1e-6

SSD_EXPAND = 2
SSD_D_INNER = SSD_EXPAND * D_MODEL
SSD_HEAD_DIM = 64
SSD_HEADS = SSD_D_INNER // SSD_HEAD_DIM
SSD_GROUPS = 8
SSD_HEADS_PER_GROUP = SSD_HEADS // SSD_GROUPS
SSD_STATE = 128
SSD_CONV = 4
SSD_CHUNK = 128
SSD_CONV_DIM = SSD_D_INNER + 2 * SSD_GROUPS * SSD_STATE
SSD_IN_DIM = SSD_D_INNER + SSD_CONV_DIM + SSD_HEADS
SSD_DT_MIN = 1e-3
SSD_DT_MAX = 1e-1

SB_HEADS = 16
SB_HEAD_DIM = D_MODEL // SB_HEADS
SB_Q_BLOCK = 128

FFN_D_FF = 2816
FFN_CONV = 3

kernel_name = "hybrid_ssd_stickbreaking_convffn"


def rms_norm(x, g):
    xf = x.astype(jnp.float32)
    y = xf * lax.rsqrt(jnp.mean(xf * xf, axis=-1, keepdims=True) + NORM_EPS)
    return (y * g.astype(jnp.float32)).astype(x.dtype)


def causal_dwconv(u, w, b):
    width = w.shape[0]
    s = u.shape[1]
    up = jnp.pad(u, ((0, 0), (width - 1, 0), (0, 0)))
    return b + sum(w[k] * up[:, k:k + s] for k in range(width))


def ssd_chunked_scan(xdt, a, bm, cm):
    bsz, s = xdt.shape[:2]
    L, G, HG, P, N = SSD_CHUNK, SSD_GROUPS, SSD_HEADS_PER_GROUP, SSD_HEAD_DIM, SSD_STATE
    nc = s // L

    def to_chunks(t):
        t = t.reshape((bsz, nc, L) + t.shape[2:])
        return jnp.moveaxis(t, 1, 0)

    xc = to_chunks(xdt.reshape(bsz, s, G, HG, P))
    ac = to_chunks(a.reshape(bsz, s, G, HG))
    bc = to_chunks(bm)
    cc = to_chunks(cm)
    causal = jnp.tril(jnp.ones((L, L), dtype=bool))[None, :, :, None, None]

    def step(state, inp):
        x_c, a_c, b_c, c_c = inp
        acum = jnp.cumsum(a_c, axis=1)
        seg = acum[:, :, None] - acum[:, None, :]
        decay = jnp.exp(jnp.where(causal, seg, -jnp.inf))
        cb = jnp.einsum('btgn,bsgn->btsg', c_c, b_c)
        scores = cb[..., None] * decay
        y_diag = jnp.einsum('btsgh,bsghp->btghp', scores, x_c)
        y_off = jnp.einsum('btgn,bghpn->btghp', c_c, state) * jnp.exp(acum)[..., None]
        last = acum[:, -1]
        w_s = jnp.exp(last[:, None] - acum)
        new_state = (state * jnp.exp(last)[..., None, None]
                     + jnp.einsum('bsgn,bsghp->bghpn', b_c, x_c * w_s[..., None]))
        return new_state, (y_diag + y_off).astype(jnp.float32)

    state0 = jnp.zeros((bsz, G, HG, P, N), jnp.float32)
    _, ys = lax.scan(step, state0, (xc, ac, bc, cc))
    return jnp.moveaxis(ys, 0, 1).reshape(bsz, s, SSD_HEADS, P)


def ssd_mixer(h, w_in, conv_w, conv_b, dt_bias, a_log, d_skip, norm_g, w_out):
    bsz, s, _ = h.shape
    proj = h @ w_in
    z, xbc, dt = jnp.split(proj, [SSD_D_INNER, SSD_D_INNER + SSD_CONV_DIM], axis=-1)
    xbc = jax.nn.silu(causal_dwconv(xbc, conv_w, conv_b))
    xs, bm, cm = jnp.split(xbc, [SSD_D_INNER, SSD_D_INNER + SSD_GROUPS * SSD_STATE], axis=-1)
    xs = xs.reshape(bsz, s, SSD_HEADS, SSD_HEAD_DIM)
    bm = bm.reshape(bsz, s, SSD_GROUPS, SSD_STATE)
    cm = cm.reshape(bsz, s, SSD_GROUPS, SSD_STATE)
    dt = jax.nn.softplus(dt.astype(jnp.float32) + dt_bias.astype(jnp.float32))
    a = -jnp.exp(a_log.astype(jnp.float32)) * dt
    y = ssd_chunked_scan(xs * dt[..., None], a, bm, cm)
    y = y + d_skip[:, None] * xs
    y = y.reshape(bsz, s, SSD_D_INNER).astype(h.dtype)
    y = rms_norm(y * jax.nn.silu(z), norm_g)
    return y @ w_out


def stick_breaking_mixer(h, w_qkv, w_out):
    bsz, s, _ = h.shape
    qkv = (h @ w_qkv).reshape(bsz, s, 3, SB_HEADS, SB_HEAD_DIM)
    q = jnp.moveaxis(qkv[:, :, 0], 1, 2)
    k = jnp.moveaxis(qkv[:, :, 1], 1, 2)
    v = jnp.moveaxis(qkv[:, :, 2], 1, 2)
    scale = SB_HEAD_DIM ** -0.5
    outs = []
    for blk in range(s // SB_Q_BLOCK):
        q0 = blk * SB_Q_BLOCK
        kv_end = q0 + SB_Q_BLOCK
        logits = jnp.einsum('bhqd,bhkd->bhqk', q[:, :, q0:kv_end], k[:, :, :kv_end]).astype(jnp.float32) * scale
        qpos = q0 + jnp.arange(SB_Q_BLOCK)[:, None]
        kpos = jnp.arange(kv_end)[None, :]
        strict = kpos < qpos
        log_beta = jax.nn.log_sigmoid(logits)
        log_fail = jnp.where(strict, jax.nn.log_sigmoid(-logits), 0.0)
        suffix = lax.cumsum(log_fail, axis=3, reverse=True) - log_fail
        weights = jnp.where(strict, jnp.exp(log_beta + suffix), 0.0)
        outs.append(jnp.einsum('bhqk,bhkd->bhqd', weights.astype(v.dtype), v[:, :, :kv_end]))
    o = jnp.concatenate(outs, axis=2)
    o = jnp.moveaxis(o, 1, 2).reshape(bsz, s, D_MODEL)
    return o @ w_out


def conv_ffn(h, w_in, conv_w, conv_b, w_out):
    u = causal_dwconv(h @ w_in, conv_w, conv_b)
    gate, up = jnp.split(u, 2, axis=-1)
    return (jax.nn.silu(gate) * up) @ w_out


def setup_inputs(seed: int = 0) -> dict:
    key = jax.random.key(seed)
    ks = jax.random.split(key, 24)
    f32 = jnp.float32
    out_scale = (2.0 * DEPTH) ** -0.5

    def nrm(k, shape, scale):
        return jax.random.normal(k, shape, f32) * scale

    x = jax.random.normal(ks[0], (BATCH, SEQ, D_MODEL), f32)
    mix_norm = 1.0 + nrm(ks[1], (DEPTH, D_MODEL), 0.02)
    ffn_norm = 1.0 + nrm(ks[2], (DEPTH, D_MODEL), 0.02)
    final_norm = 1.0 + nrm(ks[3], (D_MODEL,), 0.02)

    ssd_w_in = nrm(ks[4], (N_SSD_LAYERS, D_MODEL, SSD_IN_DIM), D_MODEL ** -0.5)
    ssd_conv_w = nrm(ks[5], (N_SSD_LAYERS, SSD_CONV, SSD_CONV_DIM), SSD_CONV ** -0.5)
    ssd_conv_b = nrm(ks[6], (N_SSD_LAYERS, SSD_CONV_DIM), 0.02)
    u = jax.random.uniform(ks[7], (N_SSD_LAYERS, SSD_HEADS), f32)
    dt0 = jnp.exp(u * (np.log(SSD_DT_MAX) - np.log(SSD_DT_MIN)) + np.log(SSD_DT_MIN))
    ssd_dt_bias = dt0 + jnp.log(-jnp.expm1(-dt0))
    ssd_a_log = jnp.log(jax.random.uniform(ks[8], (N_SSD_LAYERS, SSD_HEADS), f32, 1.0, 16.0))
    ssd_d = 1.0 + nrm(ks[9], (N_SSD_LAYERS, SSD_HEADS), 0.1)
    ssd_norm = 1.0 + nrm(ks[10], (N_SSD_LAYERS, SSD_D_INNER), 0.02)
    ssd_w_out = nrm(ks[11], (N_SSD_LAYERS, SSD_D_INNER, D_MODEL), SSD_D_INNER ** -0.5 * out_scale)

    sb_w_qkv = nrm(ks[12], (N_SB_LAYERS, D_MODEL, 3 * D_MODEL), D_MODEL ** -0.5)
    sb_w_out = nrm(ks[13], (N_SB_LAYERS, D_MODEL, D_MODEL), D_MODEL ** -0.5 * out_scale)

    ffn_w_in = nrm(ks[14], (DEPTH, D_MODEL, 2 * FFN_D_FF), D_MODEL ** -0.5)
    ffn_conv_w = nrm(ks[15], (DEPTH, FFN_CONV, 2 * FFN_D_FF), FFN_CONV ** -0.5)
    ffn_conv_b = nrm(ks[16], (DEPTH, 2 * FFN_D_FF), 0.02)
    ffn_w_out = nrm(ks[17], (DEPTH, FFN_D_FF, D_MODEL), FFN_D_FF ** -0.5 * out_scale)

    return {"x": x, "mix_norm": mix_norm, "ffn_norm": ffn_norm, "final_norm": final_norm,
            "ssd_w_in": ssd_w_in, "ssd_conv_w": ssd_conv_w, "ssd_conv_b": ssd_conv_b,
            "ssd_dt_bias": ssd_dt_bias, "ssd_a_log": ssd_a_log, "ssd_d": ssd_d,
            "ssd_norm": ssd_norm, "ssd_w_out": ssd_w_out,
            "sb_w_qkv": sb_w_qkv, "sb_w_out": sb_w_out,
            "ffn_w_in": ffn_w_in, "ffn_conv_w": ffn_conv_w, "ffn_conv_b": ffn_conv_b,
            "ffn_w_out": ffn_w_out}


def reference(x, mix_norm, ffn_norm, final_norm,
              ssd_w_in, ssd_conv_w, ssd_conv_b, ssd_dt_bias, ssd_a_log, ssd_d, ssd_norm, ssd_w_out,
              sb_w_qkv, sb_w_out,
              ffn_w_in, ffn_conv_w, ffn_conv_b, ffn_w_out):
    for i in range(DEPTH):
        h = rms_norm(x, mix_norm[i])
        j = i // N_MIXERS
        if i % N_MIXERS == 0:
            x = x + ssd_mixer(h, ssd_w_in[j], ssd_conv_w[j], ssd_conv_b[j], ssd_dt_bias[j],
                              ssd_a_log[j], ssd_d[j], ssd_norm[j], ssd_w_out[j])
        else:
            x = x + stick_breaking_mixer(h, sb_w_qkv[j], sb_w_out[j])
        x = x + conv_ffn(rms_norm(x, ffn_norm[i]), ffn_w_in[i], ffn_conv_w[i], ffn_conv_b[i], ffn_w_out[i])
    return rms_norm(x, final_norm)
```

```cpp
#include <hip/hip_runtime.h>
#include <hip/hip_cooperative_groups.h>
#include <cstdio>
#include <cstdint>
namespace cg = cooperative_groups;

#define LAS __attribute__((address_space(3)))
typedef unsigned short bf16_t;
typedef short bf16x8 __attribute__((ext_vector_type(8)));
typedef float f32x4 __attribute__((ext_vector_type(4)));
typedef float f32x16 __attribute__((ext_vector_type(16)));
typedef unsigned u32x4 __attribute__((ext_vector_type(4)));
typedef unsigned u32x2 __attribute__((ext_vector_type(2)));
typedef float f32x2_t __attribute__((ext_vector_type(2)));
typedef __bf16 bf16x2_t __attribute__((ext_vector_type(2)));

constexpr int T = 32768, SEQ = 4096, DM = 1024;
constexpr int SSD_DI = 2048, SSD_CONVD = 4096, SSD_IN = 6176, SSD_H = 32;
constexpr int FF = 2816;
constexpr float EPS = 1e-6f;
constexpr int NTHREADS = 512;

constexpr size_t MiB = 1u << 20;
constexpr size_t WS_BAR = 0;
constexpr size_t WS_SS0 = 128 * 1024;
constexpr size_t WS_SS1 = 384 * 1024;
constexpr size_t WS_SSG = 640 * 1024;
constexpr size_t WS_WMI = 1 * MiB;
constexpr size_t WS_WMO = 14 * MiB;
constexpr size_t WS_WFI = 18 * MiB;
constexpr size_t WS_WFO = 30 * MiB;
constexpr size_t WS_H   = 37 * MiB;
constexpr size_t WS_ACT = 102 * MiB;
constexpr size_t WS_Z   = WS_ACT;
constexpr size_t WS_XBC = WS_ACT + 128 * MiB;
constexpr size_t WS_DT  = WS_ACT + 384 * MiB;
constexpr size_t WS_Q   = WS_ACT;
constexpr size_t WS_K   = WS_ACT + 64 * MiB;
constexpr size_t WS_VT  = WS_ACT + 128 * MiB;
constexpr size_t WS_O   = WS_ACT + 192 * MiB;
constexpr size_t WS_A   = WS_ACT;
constexpr size_t WS_PB  = WS_ACT + 200 * MiB;
constexpr size_t WS_UB  = WS_ACT + 208 * MiB;
constexpr size_t WS_END = WS_ACT + 388 * MiB;

constexpr int LDS_BYTES = 151552;
constexpr int RING_BYTES = 131072;

struct Params {
  const float* x; const float* mix_norm; const float* ffn_norm; const float* final_norm;
  const float* ssd_w_in; const float* ssd_conv_w; const float* ssd_conv_b; const float* ssd_dt_bias; const float* ssd_a_log; const float* ssd_d;
  const float* ssd_norm; const float* ssd_w_out; const float* sb_w_qkv; const float* sb_w_out;
  const float* ffn_w_in; const float* ffn_conv_w; const float* ffn_conv_b; const float* ffn_w_out;
  float* out; unsigned char* ws;
};

__device__ __forceinline__ unsigned cvtpk(float lo, float hi) { f32x2_t v = {lo, hi}; bf16x2_t b = __builtin_convertvector(v, bf16x2_t); return __builtin_bit_cast(unsigned, b); }
__device__ __forceinline__ bf16_t f2bf(float f) { return (bf16_t)(cvtpk(f, 0.f) & 0xffffu); }
__device__ __forceinline__ float bf2f(bf16_t h) { return __uint_as_float((unsigned)h << 16); }
__device__ __forceinline__ float bflo(unsigned w) { return __uint_as_float(w << 16); }
__device__ __forceinline__ float bfhi(unsigned w) { return __uint_as_float(w & 0xffff0000u); }
constexpr float SS_SCALE = 4096.f, SS_INV = 1.f / 4096.f;
__device__ __forceinline__ int ss_q(float s) { return __float2int_rn(fminf(s * SS_SCALE, 1.0e9f)); }
__device__ __forceinline__ float ss_f(float raw_bits) { return (float)__float_as_int(raw_bits) * SS_INV; }
__device__ __forceinline__ float silu_f(float x) { return x * __builtin_amdgcn_rcpf(1.f + __expf(-x)); }
__device__ __forceinline__ float wave_sum(float v) {
#pragma unroll
  for (int o = 1; o < 64; o <<= 1) v += __shfl_xor(v, o);
  return v;
}
template <int D> __device__ __forceinline__ float rot16(float v) {
  return __int_as_float(__builtin_amdgcn_update_dpp(0, __float_as_int(v), 0x120 + D, 0xf, 0xf, false));
}
template <int D> __device__ __forceinline__ f32x4 rot16x4(f32x4 v) { f32x4 r; r[0] = rot16<D>(v[0]); r[1] = rot16<D>(v[1]); r[2] = rot16<D>(v[2]); r[3] = rot16<D>(v[3]); return r; }
__device__ __forceinline__ f32x16 mfma32(bf16x8 a, bf16x8 b, f32x16 c) { return __builtin_amdgcn_mfma_f32_32x32x16_bf16(a, b, c, 0, 0, 0); }


#define XB_TMO      128
#define XB_XCNT(j)  (256  + 64 * (j))
#define XB_XSUB(j)  (1280 + 64 * (j))
#define XB_XGEN(j)  (2304 + 64 * (j))
#define XB_TOP      3328
#define XB_TOPGEN   3392
#define XCD_BAR_WORDS 3456
#define XB_SPIN_CAP (1u << 18)
__device__ __forceinline__ unsigned xb_ld(unsigned* p)              { return __hip_atomic_load(p, __ATOMIC_RELAXED, __HIP_MEMORY_SCOPE_AGENT); }
__device__ __forceinline__ unsigned xb_add(unsigned* p, unsigned v) { return __hip_atomic_fetch_add(p, v, __ATOMIC_RELAXED, __HIP_MEMORY_SCOPE_AGENT); }
__device__ __forceinline__ unsigned xb_xcc_id() { return (unsigned)__builtin_amdgcn_s_getreg((3 << 11) | 20) & 0xFu; }
#define XB_SPIN(cond, bar) do { unsigned _sp = 0; while (cond) { __builtin_amdgcn_s_sleep(1); \
    if ((++_sp & 255u) == 0u) { if (xb_ld(&(bar)[XB_TMO])) break; if (_sp > XB_SPIN_CAP) { atomicAdd(&(bar)[XB_TMO], 1u); break; } } } } while (0)
struct XcdBarrier { unsigned* bar; unsigned x; volatile LAS unsigned* st; };
__device__ __forceinline__ XcdBarrier xcd_barrier_post(unsigned* bar, volatile LAS unsigned* st) {
  XcdBarrier b; b.bar = bar; b.x = xb_xcc_id(); b.st = st;
  if (threadIdx.x == 0) (void)xb_add(&bar[XB_XCNT(b.x)], 1u);
  return b;
}
__device__ __forceinline__ void xcd_barrier_complete(unsigned* bar, unsigned x, unsigned& nloc, unsigned& nx) {
  const unsigned G = gridDim.x * gridDim.y * gridDim.z;
  unsigned sum, cnt, mine, sp = 0u;
  for (;;) {
    sum = 0u; cnt = 0u; mine = 0u;
#pragma unroll
    for (unsigned j = 0; j < 16; ++j) { const unsigned c = xb_ld(&bar[XB_XCNT(j)]); sum += c; cnt += (c > 0u) ? 1u : 0u; mine = (j == x) ? c : mine; }
    if (sum == G) break;
    __builtin_amdgcn_s_sleep(1);
    if ((++sp & 255u) == 0u) { if (xb_ld(&bar[XB_TMO])) break; if (sp > XB_SPIN_CAP) { atomicAdd(&bar[XB_TMO], 1u); break; } }
  }
  nloc = mine > 0u ? mine : 1u; nx = cnt > 0u ? cnt : 1u;
}
__device__ __forceinline__ void xcd_barrier(const XcdBarrier& b) {
  asm volatile("s_waitcnt vmcnt(0)" ::: "memory");
  __syncthreads();
  if (threadIdx.x == 0) {
    unsigned* bar = b.bar;
    __builtin_amdgcn_s_waitcnt(0);
    unsigned nloc = b.st[0], nx = b.st[1];
    if (nloc == 0u) { xcd_barrier_complete(bar, b.x, nloc, nx); b.st[0] = nloc; b.st[1] = nx; }
    const unsigned old = xb_add(&bar[XB_XSUB(b.x)], 1u);
    const unsigned gen = old / nloc;
    if (old + 1u == (gen + 1u) * nloc) {
      __builtin_amdgcn_fence(__ATOMIC_RELEASE, "agent");
      asm volatile("s_waitcnt vmcnt(0)" ::: "memory");
      const unsigned og = xb_add(&bar[XB_TOP], 1u);
      const unsigned tg = og / nx;
      if (og + 1u == (tg + 1u) * nx) xb_add(&bar[XB_TOPGEN], 1u);
      else XB_SPIN(xb_ld(&bar[XB_TOPGEN]) == tg, bar);
      __builtin_amdgcn_fence(__ATOMIC_ACQUIRE, "agent");
      xb_add(&bar[XB_XGEN(b.x)], 1u);
      asm volatile("s_waitcnt vmcnt(0)" ::: "memory");
    } else {
      XB_SPIN(xb_ld(&bar[XB_XGEN(b.x)]) == gen, bar);
      __builtin_amdgcn_fence(__ATOMIC_ACQUIRE, "agent");
      asm volatile("s_waitcnt vmcnt(0)" ::: "memory");
    }
  }
  __syncthreads();
}

namespace pg8 {
constexpr int BM = 256, BK = 64, HALF = 128, HTB = HALF * BK * 2, NXCD = 8, WGM = 4;
__device__ __forceinline__ int lds_byte(int r, int c) { const int st = (r >> 4) * 2 + (c >> 5), rr = r & 15, cc = c & 31, ob = rr * 64 + cc * 2; return st * 1024 + (ob ^ (((ob >> 9) & 1) << 5)); }
__device__ __forceinline__ void stage_rc(int b, int& R, int& C) { const int st = b / 1024, sb = b % 1024, swz = sb ^ (((sb >> 9) & 1) << 5); R = (st >> 1) * 16 + swz / 64; C = (st & 1) * 32 + (swz % 64) / 2; }
__device__ __forceinline__ int perm32(int rho) { const int n = rho >> 4, i = rho & 15; return 8 * (i >> 2) + 4 * n + (i & 3); }

struct Unit { int pm, pn; };
struct Gemm { const bf16_t* A; const bf16_t* Bt; int nM, nN, K, rstep, roff; };

struct StaticOrder {
  int nM, nN, nwg, G, c;
  __device__ void init(int nM_, int nN_, int G_, int c_) { nM = nM_; nN = nN_; nwg = nM * nN; G = G_; c = c_; }
  __device__ bool next(int i, Unit& u) const {
    const long L = (long)i * G + c; if (L >= nwg) return false;
    int wgid = (int)L; { const int q = nwg / NXCD, r = nwg % NXCD, xcd = wgid % NXCD, off = wgid / NXCD; wgid = (xcd < r ? xcd * (q + 1) : r * (q + 1) + (xcd - r) * q) + off; }
    const int nig = WGM * nN, gid = wgid / nig, fm = gid * WGM, gsz = (nM - fm) < WGM ? (nM - fm) : WGM;
    u.pm = fm + ((wgid % nig) % gsz); u.pn = (wgid % nig) / gsz; return true;
  }
};

template <class Epi>
__device__ __forceinline__ void gemm_phase(LAS unsigned char* lds, const Gemm g, const StaticOrder& S, const Epi& E) {
  int tid = threadIdx.x; asm volatile("" : "+v"(tid));
  const int wid = __builtin_amdgcn_readfirstlane(tid >> 6), lane = tid & 63, wr = wid >> 2, wc = wid & 3, fr = lane & 15, fq = lane >> 4;
  const int K = g.K, nt = K / BK;
  unsigned voffA[2], voffB[2];
#pragma unroll
  for (int i = 0; i < 2; ++i) { int R, C; stage_rc(tid * 16 + i * 8192, R, C); const int Rb = Epi::PERM ? ((R & ~31) + perm32(R & 31)) : R;
    voffA[i] = (unsigned)(R * K + C) * 2u; voffB[i] = (unsigned)(Rb * K + C) * 2u; }
  const size_t kstep = (size_t)(BK * 2);
  const size_t hstep = (size_t)HALF * K * 2;
  const size_t tstepB = 2 * hstep;
  const long rowb = (long)K * 2;
  const unsigned ldsw = (unsigned)wid * 1024u;
  const int aoff = lds_byte(wr * 64 + fr, fq * 8), boff = lds_byte(wc * 32 + fr, fq * 8);
#define PG8_SA(b, h) (((b) * 2 + (h)) * HTB)
#define PG8_SB(b, h) ((4 + (b) * 2 + (h)) * HTB)
#define PG8_STAGE(bufoff, gbase, voff) do { _Pragma("unroll") for (int _i = 0; _i < 2; ++_i) \
    __builtin_amdgcn_global_load_lds((const unsigned*)((const char*)(gbase) + (voff)[_i]), (LAS unsigned*)(lds + (bufoff) + ldsw + _i * 8192), 16, 0, 0); } while (0)
#define PG8_LDA(dst, b, h) do { _Pragma("unroll") for (int m = 0; m < 4; ++m) _Pragma("unroll") for (int k = 0; k < 2; ++k) dst[m][k] = *(const LAS bf16x8*)(lds + PG8_SA(b, h) + aoff + m * 2048 + k * 1024); } while (0)
#define PG8_LDB(dst, b, h) do { _Pragma("unroll") for (int n = 0; n < 2; ++n) _Pragma("unroll") for (int k = 0; k < 2; ++k) dst[n][k] = *(const LAS bf16x8*)(lds + PG8_SB(b, h) + boff + n * 2048 + k * 1024); } while (0)
#define PG8_MMA(ai, bj, At, Bt) do { __builtin_amdgcn_s_setprio(1); _Pragma("unroll") for (int m = 0; m < 4; ++m) _Pragma("unroll") for (int n = 0; n < 2; ++n) _Pragma("unroll") for (int k = 0; k < 2; ++k) \
    acc[ai][bj][m][n] = __builtin_amdgcn_mfma_f32_16x16x32_bf16(Bt[n][k], At[m][k], acc[ai][bj][m][n], 0, 0, 0); __builtin_amdgcn_s_setprio(0); } while (0)
#define PG8_WAIT_V(n) asm volatile("s_waitcnt vmcnt(" #n ")" ::: "memory")
#define PG8_WAIT_L(n) asm volatile("s_waitcnt lgkmcnt(" #n ")" ::: "memory")
#define PG8_BAR __builtin_amdgcn_s_barrier()
#define PG8_SCHED __builtin_amdgcn_sched_barrier(0)
  Unit cur, nxt; int ui = 0;
  if (!S.next(0, cur)) return;
  f32x4 acc[2][2][4][2];
#pragma unroll
  for (int a = 0; a < 2; ++a)
#pragma unroll
    for (int b = 0; b < 2; ++b)
#pragma unroll
      for (int m = 0; m < 4; ++m)
#pragma unroll
        for (int n = 0; n < 2; ++n) acc[a][b][m][n] = (f32x4){0.f, 0.f, 0.f, 0.f};
  bf16x8 At[4][2], B0[2][2], B1[2][2];
  const char* cA = (const char*)g.A + ((long)cur.pm * g.rstep + g.roff) * rowb; const char* cB = (const char*)g.Bt + (size_t)cur.pn * tstepB;
  PG8_STAGE(PG8_SB(0, 0), cB, voffB); PG8_STAGE(PG8_SB(0, 1), cB + hstep, voffB); PG8_STAGE(PG8_SA(0, 0), cA, voffA); PG8_STAGE(PG8_SA(0, 1), cA + hstep, voffA);
  if (wr == 1) PG8_BAR;
  PG8_WAIT_V(2); PG8_BAR;
  PG8_STAGE(PG8_SB(1, 0), cB + kstep, voffB); PG8_STAGE(PG8_SA(1, 0), cA + kstep, voffA); PG8_STAGE(PG8_SB(1, 1), cB + hstep + kstep, voffB);
  PG8_WAIT_V(6); PG8_BAR;
  if (wr == 1) { int lp = lane; asm volatile("" : "+v"(lp)); E.prefetch(cur, lp, wc); }
  for (;;) {
    const bool has_next = S.next(ui + 1, nxt);
    const char* nA = has_next ? (const char*)g.A + ((long)nxt.pm * g.rstep + g.roff) * rowb : cA; const char* nB = has_next ? (const char*)g.Bt + (size_t)nxt.pn * tstepB : cB;
    for (int t = 0; t < nt; t += 2) {
      const bool last = (t == nt - 2);
      const char* a1 = cA + (size_t)(t + 1) * kstep;
      const char* a2 = last ? nA : cA + (size_t)(t + 2) * kstep; const char* b2 = last ? nB : cB + (size_t)(t + 2) * kstep;
      const char* a3 = a2 + kstep; const char* b3 = b2 + kstep;
      PG8_LDB(B0, 0, 0); PG8_LDB(B1, 0, 1); PG8_SCHED; PG8_LDA(At, 0, 0); PG8_STAGE(PG8_SA(1, 1), a1 + hstep, voffA);
      PG8_WAIT_V(8); PG8_WAIT_L(0); PG8_BAR; PG8_MMA(0, 0, At, B0); PG8_MMA(0, 1, At, B1); PG8_BAR; PG8_SCHED;
      PG8_LDA(At, 0, 1); PG8_STAGE(PG8_SB(0, 0), b2, voffB); PG8_STAGE(PG8_SB(0, 1), b2 + hstep, voffB); PG8_STAGE(PG8_SA(0, 0), a2, voffA);
      PG8_WAIT_V(8); PG8_WAIT_L(0); PG8_BAR; PG8_MMA(1, 0, At, B0); PG8_MMA(1, 1, At, B1); PG8_BAR; PG8_SCHED;
      PG8_LDB(B0, 1, 0); PG8_LDB(B1, 1, 1); PG8_SCHED; PG8_LDA(At, 1, 0); PG8_STAGE(PG8_SA(0, 1), a2 + hstep, voffA);
      PG8_WAIT_V(8); PG8_WAIT_L(0); PG8_BAR; PG8_MMA(0, 0, At, B0); PG8_MMA(0, 1, At, B1); PG8_BAR; PG8_SCHED;
      PG8_LDA(At, 1, 1); PG8_STAGE(PG8_SB(1, 0), b3, voffB); PG8_STAGE(PG8_SB(1, 1), b3 + hstep, voffB); PG8_STAGE(PG8_SA(1, 0), a3, voffA);
      PG8_WAIT_V(8); PG8_WAIT_L(0); PG8_BAR; PG8_MMA(1, 0, At, B0); PG8_MMA(1, 1, At, B1); PG8_BAR; PG8_SCHED;
    }
    if (wr == 0) PG8_BAR;
    E(acc, cur, wr, wc, fr, fq);
    if (!has_next) break;
#pragma unroll
    for (int a = 0; a < 2; ++a)
#pragma unroll
      for (int b = 0; b < 2; ++b)
#pragma unroll
        for (int m = 0; m < 4; ++m)
#pragma unroll
          for (int n = 0; n < 2; ++n) acc[a][b][m][n] = (f32x4){0.f, 0.f, 0.f, 0.f};
    cur = nxt; cA = nA; cB = nB; ++ui;
    if (wr == 1) { PG8_BAR;
      int lp = lane; asm volatile("" : "+v"(lp)); E.prefetch(cur, lp, wc); }
  }
  PG8_WAIT_V(0);
  PG8_BAR;
#undef PG8_SA
#undef PG8_SB
#undef PG8_STAGE
#undef PG8_LDA
#undef PG8_LDB
#undef PG8_MMA
#undef PG8_WAIT_V
#undef PG8_WAIT_L
#undef PG8_BAR
#undef PG8_SCHED
}

struct EpiRes {
  static constexpr bool PERM = true;
  bf16_t* hi; float* ss; const float* ssg; LAS float* rtab;
  __device__ __forceinline__ void prefetch(const Unit& u, int lane, int w4) const { if (ssg) __builtin_amdgcn_global_load_lds((const unsigned*)(ssg + u.pm * BM + 64 * w4 + lane), (LAS unsigned*)(rtab + 64 * w4), 4, 0, 0); }
  __device__ __forceinline__ void operator()(f32x4 (&acc)[2][2][4][2], const Unit& u, int wr, int wc, int fr_, int fq_) const {
    int fr = fr_, fq = fq_; asm volatile("" : "+v"(fr), "+v"(fq));
    const int col0 = u.pn * BM + wc * 32 + 8 * fq;
    float part[2][4];
    u32x4 ph[2][4][2];
#pragma unroll
    for (int ai = 0; ai < 2; ++ai)
#pragma unroll
      for (int m = 0; m < 4; ++m) { const unsigned off = (unsigned)(u.pm * BM + ai * HALF + wr * 64 + m * 16 + fr) * DM + col0;
#pragma unroll
        for (int bj = 0; bj < 2; ++bj) ph[ai][m][bj] = *(const u32x4*)(hi + off + bj * HALF); }
    asm volatile("" ::: "memory");
#pragma unroll
    for (int ai = 0; ai < 2; ++ai)
#pragma unroll
      for (int m = 0; m < 4; ++m) { const unsigned off = (unsigned)(u.pm * BM + ai * HALF + wr * 64 + m * 16 + fr) * DM + col0;
        const float rs = ssg ? rsqrtf(ss_f(rtab[ai * HALF + wr * 64 + m * 16 + fr]) * (1.f / SSD_DI) + EPS) : 1.f; float p = 0.f;
#pragma unroll
        for (int bj = 0; bj < 2; ++bj) { u32x4 wh;
#pragma unroll
          for (int n = 0; n < 2; ++n) {
            const unsigned h0 = ph[ai][m][bj][2 * n], h1 = ph[ai][m][bj][2 * n + 1]; const f32x4 a = acc[ai][bj][m][n];
            const float v0 = bflo(h0) + a[0] * rs, v1 = bfhi(h0) + a[1] * rs, v2 = bflo(h1) + a[2] * rs, v3 = bfhi(h1) + a[3] * rs;
            wh[2 * n] = cvtpk(v0, v1); wh[2 * n + 1] = cvtpk(v2, v3); p += (v0 * v0 + v1 * v1) + (v2 * v2 + v3 * v3); }
          *(u32x4*)(hi + off + bj * HALF) = wh; }
        part[ai][m] = p; }
    asm volatile("" ::: "memory");
#pragma unroll
    for (int ai = 0; ai < 2; ++ai)
#pragma unroll
      for (int m = 0; m < 4; ++m) { float p = part[ai][m]; p += __shfl_xor(p, 16); p += __shfl_xor(p, 32);
        if (fq == 0) atomicAdd((int*)ss + u.pm * BM + ai * HALF + wr * 64 + m * 16 + fr, ss_q(p)); }
  }
};

struct EpiQkv {
  static constexpr bool PERM = true;
  bf16_t* Q; bf16_t* Kb; bf16_t* Vt; const float* ssin; LAS float* rtab;
  __device__ __forceinline__ void prefetch(const Unit& u, int lane, int w4) const { __builtin_amdgcn_global_load_lds((const unsigned*)(ssin + u.pm * BM + 64 * w4 + lane), (LAS unsigned*)(rtab + 64 * w4), 4, 0, 0); }
  __device__ __forceinline__ void operator()(f32x4 (&acc)[2][2][4][2], const Unit& u, int wr, int wc, int fr_, int fq_) const {
    int fr = fr_, fq = fq_; asm volatile("" : "+v"(fr), "+v"(fq));
#pragma unroll
    for (int ai = 0; ai < 2; ++ai)
#pragma unroll
      for (int m = 0; m < 4; ++m) { const float rs = rsqrtf(ss_f(rtab[ai * HALF + wr * 64 + m * 16 + fr]) * (1.f / DM) + EPS);
#pragma unroll
        for (int bj = 0; bj < 2; ++bj) { acc[ai][bj][m][0] *= rs; acc[ai][bj][m][1] *= rs; } }
    const int sec = u.pn >> 2, colt = (u.pn & 3) * BM + wc * 32 + 8 * fq;
    if (sec < 2) {
      bf16_t* base = sec == 0 ? Q : Kb; const float sc = sec == 0 ? 0.125f : 1.f;
#pragma unroll
      for (int ai = 0; ai < 2; ++ai)
#pragma unroll
        for (int m = 0; m < 4; ++m) { bf16_t* rowp = base + (size_t)(u.pm * BM + ai * HALF + wr * 64 + m * 16 + fr) * DM + colt;
#pragma unroll
          for (int bj = 0; bj < 2; ++bj) { const f32x4 v0 = acc[ai][bj][m][0] * sc, v1 = acc[ai][bj][m][1] * sc; u32x4 w; w.x = cvtpk(v0[0], v0[1]); w.y = cvtpk(v0[2], v0[3]); w.z = cvtpk(v1[0], v1[1]); w.w = cvtpk(v1[2], v1[3]);
            *(u32x4*)(rowp + bj * HALF) = w; } }
    } else {
#pragma unroll
      for (int ai = 0; ai < 2; ++ai)
#pragma unroll
        for (int m = 0; m < 4; ++m) { const int r = u.pm * BM + ai * HALF + wr * 64 + m * 16 + fr; const int b = r >> 12, s = r & 4095;
#pragma unroll
          for (int bj = 0; bj < 2; ++bj)
#pragma unroll
            for (int n = 0; n < 2; ++n)
#pragma unroll
              for (int j = 0; j < 4; ++j) { const int c = colt + bj * HALF + 4 * n + j;
                Vt[((size_t)(b * 1024 + c)) * SEQ + s] = f2bf(acc[ai][bj][m][n][j]); } }
    }
  }
};

template <int HALO> struct ConvCarry {
  LAS float* carry;
  __device__ __forceinline__ void publish(const f32x4 (&acc)[2][2][4][2], int wr, int wc, int fr, int fq) const {
    if (fr >= 16 - HALO) {
#pragma unroll
      for (int ai = 0; ai < 2; ++ai)
#pragma unroll
        for (int bj = 0; bj < 2; ++bj)
#pragma unroll
          for (int n = 0; n < 2; ++n) *(LAS f32x4*)(carry + ((2 * ai + wr) * HALO + (fr - (16 - HALO))) * 256 + 128 * bj + 32 * wc + 8 * fq + 4 * n) = acc[ai][bj][3][n];
    }
    asm volatile("s_waitcnt lgkmcnt(0)" ::: "memory"); __builtin_amdgcn_s_barrier(); asm volatile("" ::: "memory");
  }
  template <int D> __device__ __forceinline__ f32x4 prev(const f32x4 (&acc)[2][2][4][2], int ai, int bj, int m, int n, int wr, int wc, int fr, int fq) const {
    f32x4 b;
    if (m == 0) { int B = 2 * ai + wr - 1; const bool none = B < 0; B = none ? 0 : B; int ri = HALO + fr - D; ri = ri > HALO - 1 ? HALO - 1 : ri;
      b = *(const LAS f32x4*)(carry + (B * HALO + ri) * 256 + 128 * bj + 32 * wc + 8 * fq + 4 * n);
      if (none) b = (f32x4){0.f, 0.f, 0.f, 0.f}; }
    else b = rot16x4<D>(acc[ai][bj][m - 1][n]);
    f32x4 r;
#pragma unroll
    for (int j = 0; j < 4; ++j) r[j] = __int_as_float(__builtin_amdgcn_update_dpp(__float_as_int(b[j]), __float_as_int(acc[ai][bj][m][n][j]), 0x110 + D, 0xf, 0xf, false));
    return r;
  }
};

struct EpiFfnIn {
  static constexpr bool PERM = true;
  bf16_t* O; const float* cw; const float* cb; ConvCarry<2> cc; const float* ssin; LAS float* rtab; LAS float* wtab; float* PB; float* UB;
  __device__ __forceinline__ void prefetch(const Unit& u, int lane, int w4) const {
    __builtin_amdgcn_global_load_lds((const unsigned*)(ssin + u.pm * 256 + 64 * w4 + lane), (LAS unsigned*)(rtab + 64 * w4), 4, 0, 0);
#pragma unroll
    for (int q = 0; q < 4; ++q) { const int ck = w4 + 4 * q, e = 64 * ck + lane, v = e >> 7, c = 128 * u.pn + (e & 127);
      const float* src = (v & 3) == 3 ? cb + (v >> 2) * FF + c : cw + ((v & 3) * 2 + (v >> 2)) * FF + c; __builtin_amdgcn_global_load_lds((const unsigned*)(src), (LAS unsigned*)(wtab + 64 * ck), 4, 0, 0); } }
  __device__ __forceinline__ void operator()(f32x4 (&acc)[2][2][4][2], const Unit& u, int wr, int wc, int fr_, int fq_) const {
    int fr = fr_, fq = fq_; asm volatile("" : "+v"(fr), "+v"(fq));
#pragma unroll
    for (int ai = 0; ai < 2; ++ai)
#pragma unroll
      for (int m = 0; m < 4; ++m) { const float rs = rsqrtf(ss_f(rtab[128 * ai + 64 * wr + 16 * m + fr]) * (1.f / DM) + EPS);
#pragma unroll
        for (int bj = 0; bj < 2; ++bj) { acc[ai][bj][m][0] *= rs; acc[ai][bj][m][1] *= rs; } }
    cc.publish(acc, wr, wc, fr, fq);
    const bool seq_start = ((u.pm * 256) & (SEQ - 1)) == 0;
    const int ch0 = 128 * u.pn + 32 * wc + 8 * fq;
    if (wr == 1 && fr >= 14) {
#pragma unroll
      for (int n = 0; n < 2; ++n) { float* ub = UB + ((size_t)u.pm * 2 + (fr - 14)) * (2 * FF) + ch0 + 4 * n; *(f32x4*)ub = acc[1][0][3][n]; *(f32x4*)(ub + FF) = acc[1][1][3][n]; } }
#pragma unroll
    for (int n = 0; n < 2; ++n) {
      const int ch = ch0 + 4 * n; const LAS float* wp = wtab + 32 * wc + 8 * fq + 4 * n;
      const f32x4 g0 = *(const LAS f32x4*)(wp), g1 = *(const LAS f32x4*)(wp + 128), g2 = *(const LAS f32x4*)(wp + 256), gb = *(const LAS f32x4*)(wp + 384);
      const f32x4 u0 = *(const LAS f32x4*)(wp + 512), u1 = *(const LAS f32x4*)(wp + 640), u2 = *(const LAS f32x4*)(wp + 768), ub = *(const LAS f32x4*)(wp + 896);
#pragma unroll
      for (int ai = 0; ai < 2; ++ai)
#pragma unroll
        for (int m = 0; m < 4; ++m) {
          const int i = 128 * ai + 64 * wr + 16 * m + fr; const int tok = u.pm * 256 + i;
          const f32x4 G1 = cc.prev<1>(acc, ai, 0, m, n, wr, wc, fr, fq), G2 = cc.prev<2>(acc, ai, 0, m, n, wr, wc, fr, fq);
          const f32x4 U1 = cc.prev<1>(acc, ai, 1, m, n, wr, wc, fr, fq), U2 = cc.prev<2>(acc, ai, 1, m, n, wr, wc, fr, fq);
          const f32x4 cg_ = gb + g2 * acc[ai][0][m][n] + g1 * G1 + g0 * G2;
          const f32x4 cu_ = ub + u2 * acc[ai][1][m][n] + u1 * U1 + u0 * U2;
          if (ai == 0 && m == 0 && !seq_start && wr == 0 && fr < 2) {
            float* pb = PB + ((size_t)u.pm * 2 + fr) * (2 * FF) + ch; *(f32x4*)pb = cg_; *(f32x4*)(pb + FF) = cu_;
          } else {
            u32x2 w; w.x = cvtpk(silu_f(cg_[0]) * cu_[0], silu_f(cg_[1]) * cu_[1]); w.y = cvtpk(silu_f(cg_[2]) * cu_[2], silu_f(cg_[3]) * cu_[3]);
            *(u32x2*)(O + (size_t)tok * FF + ch) = w;
          }
        }
      asm volatile("" ::: "memory");
    }
  }
};

struct EpiSsdIn {
  static constexpr bool PERM = true;
  bf16_t* Z; bf16_t* XBC; float* DT; const float* cw; const float* cb; const float* dtb; ConvCarry<3> cc; const float* ssin; LAS float* rtab; LAS float* wtab;
  __device__ __forceinline__ void prefetch(const Unit& u, int lane, int w4) const {
    { int tok = u.pm * 253 - 3 + 64 * w4 + lane; tok = tok < 0 ? 0 : (tok > T - 1 ? T - 1 : tok); __builtin_amdgcn_global_load_lds((const unsigned*)(ssin + tok), (LAS unsigned*)(rtab + 64 * w4), 4, 0, 0); }
    if (u.pn >= 8 && u.pn < 24) {
#pragma unroll
      for (int q = 0; q < 5; ++q) { const int ck = w4 + 4 * q, e = 64 * ck + lane, v = e >> 8, c = (u.pn - 8) * BM + (e & 255); const float* src = v == 4 ? cb + c : cw + v * SSD_CONVD + c; __builtin_amdgcn_global_load_lds((const unsigned*)(src), (LAS unsigned*)(wtab + 64 * ck), 4, 0, 0); } } }
  __device__ __forceinline__ void operator()(f32x4 (&acc)[2][2][4][2], const Unit& u, int wr, int wc, int fr_, int fq_) const {
    int fr = fr_, fq = fq_; asm volatile("" : "+v"(fr), "+v"(fq));
#pragma unroll
    for (int ai = 0; ai < 2; ++ai)
#pragma unroll
      for (int m = 0; m < 4; ++m) { const float rs = rsqrtf(ss_f(rtab[128 * ai + 64 * wr + 16 * m + fr]) * (1.f / DM) + EPS);
#pragma unroll
        for (int bj = 0; bj < 2; ++bj) { acc[ai][bj][m][0] *= rs; acc[ai][bj][m][1] *= rs; } }
    if (u.pn < 8) {
      const int col0 = u.pn * BM + wc * 32 + 8 * fq;
#pragma unroll
      for (int ai = 0; ai < 2; ++ai)
#pragma unroll
        for (int m = 0; m < 4; ++m) { const int i = 128 * ai + 64 * wr + 16 * m + fr; const int tok = u.pm * 253 - 3 + i;
          if (i >= 3 && tok < T) {
#pragma unroll
            for (int bj = 0; bj < 2; ++bj) { const f32x4 v0 = acc[ai][bj][m][0], v1 = acc[ai][bj][m][1]; u32x4 w; w.x = cvtpk(v0[0], v0[1]); w.y = cvtpk(v0[2], v0[3]); w.z = cvtpk(v1[0], v1[1]); w.w = cvtpk(v1[2], v1[3]);
              *(u32x4*)(Z + (size_t)tok * SSD_DI + col0 + bj * HALF) = w; } } }
    } else if (u.pn < 24) {
      cc.publish(acc, wr, wc, fr, fq);
      const int tlo = u.pm * 253 - 3; const bool has_bnd = tlo < 0 || (tlo & (SEQ - 1)) + 255 >= SEQ || (tlo & (SEQ - 1)) < 3;
      const int ch0 = (u.pn - 8) * BM + wc * 32 + 8 * fq;
#pragma unroll
      for (int bj = 0; bj < 2; ++bj)
#pragma unroll
        for (int n = 0; n < 2; ++n) {
          const int ch = ch0 + 128 * bj + 4 * n; const LAS float* wp = wtab + 128 * bj + 32 * wc + 8 * fq + 4 * n;
          const f32x4 w0 = *(const LAS f32x4*)(wp), w1 = *(const LAS f32x4*)(wp + 256), w2 = *(const LAS f32x4*)(wp + 512), w3 = *(const LAS f32x4*)(wp + 768), bb = *(const LAS f32x4*)(wp + 1024);
#pragma unroll
          for (int ai = 0; ai < 2; ++ai)
#pragma unroll
            for (int m = 0; m < 4; ++m) {
              const int i = 128 * ai + 64 * wr + 16 * m + fr; const int tok = u.pm * 253 - 3 + i; const int tb = tok & (SEQ - 1);
              f32x4 V1 = cc.prev<1>(acc, ai, bj, m, n, wr, wc, fr, fq), V2 = cc.prev<2>(acc, ai, bj, m, n, wr, wc, fr, fq), V3 = cc.prev<3>(acc, ai, bj, m, n, wr, wc, fr, fq);
              if (has_bnd) { const f32x4 zero = {0.f, 0.f, 0.f, 0.f}; if (tb < 1) V1 = zero; if (tb < 2) V2 = zero; if (tb < 3) V3 = zero; }
              const f32x4 c_ = bb + w3 * acc[ai][bj][m][n] + w2 * V1 + w1 * V2 + w0 * V3;
              u32x2 w; w.x = cvtpk(silu_f(c_[0]), silu_f(c_[1])); w.y = cvtpk(silu_f(c_[2]), silu_f(c_[3]));
              if (i >= 3 && tok < T) *(u32x2*)(XBC + (size_t)tok * SSD_CONVD + ch) = w;
            }
          asm volatile("" ::: "memory");
        }
    } else {
      if (wc == 0) {
#pragma unroll
        for (int n = 0; n < 2; ++n) { const int c = 8 * fq + 4 * n; const f32x4 bv = *(const f32x4*)(dtb + c);
#pragma unroll
          for (int ai = 0; ai < 2; ++ai)
#pragma unroll
            for (int m = 0; m < 4; ++m) { const int i = 128 * ai + 64 * wr + 16 * m + fr; const int tok = u.pm * 253 - 3 + i;
              f32x4 v = acc[ai][0][m][n] + bv;
#pragma unroll
              for (int j = 0; j < 4; ++j) v[j] = fmaxf(v[j], 0.f) + log1pf(__expf(-fabsf(v[j])));
              if (i >= 3 && tok < T) *(f32x4*)(DT + (size_t)tok * SSD_H + c) = v; } }
      }
    }
  }
};
}

__device__ __forceinline__ void transpose_item(const float* W, const float* gk, int K, int N, bf16_t* WT, int k0, int n0, int drow0, LAS float* scr, int lane) {
  f32x4 v[8];
#pragma unroll
  for (int i = 0; i < 8; ++i) v[i] = *(const f32x4*)(W + (size_t)(k0 + 8 * i + (lane >> 3)) * N + n0 + 4 * (lane & 7));
#pragma unroll
  for (int i = 0; i < 8; ++i) { const int kk = 8 * i + (lane >> 3); const float g = gk ? gk[k0 + kk] : 1.f; LAS float* d = scr + kk * 33 + 4 * (lane & 7);
    d[0] = v[i].x * g; d[1] = v[i].y * g; d[2] = v[i].z * g; d[3] = v[i].w * g; }
  asm volatile("s_waitcnt lgkmcnt(0)" ::: "memory");
  const int c = lane & 7;
#pragma unroll
  for (int j = 0; j < 4; ++j) { const int n = (lane >> 3) + 8 * j; const LAS float* s = scr + (8 * c) * 33 + n;
    u32x4 o; o.x = cvtpk(s[0 * 33], s[1 * 33]); o.y = cvtpk(s[2 * 33], s[3 * 33]); o.z = cvtpk(s[4 * 33], s[5 * 33]); o.w = cvtpk(s[6 * 33], s[7 * 33]);
    *(u32x4*)(WT + (size_t)(drow0 + n) * K + k0 + 8 * c) = o; }
  asm volatile("s_waitcnt lgkmcnt(0)" ::: "memory");
}
__device__ __forceinline__ void convert_weight(const float* W, const float* gk, int K, int N, bf16_t* WT, int kind, LAS float* scr, int gw, int ngw, int lane) {
  const int nblk = N / 32, items = (K / 64) * nblk;
  for (int it = gw; it < items; it += ngw) {
    const int kb = it / nblk, nb = it % nblk, n0 = nb * 32;
    int drow0 = n0;
    if (kind == 1) { drow0 = n0 < FF ? (256 * (n0 >> 7) + (n0 & 127)) : (256 * ((n0 - FF) >> 7) + 128 + ((n0 - FF) & 127)); }
    transpose_item(W, gk, K, N, WT, kb * 64, n0, drow0, scr, lane);
  }
}
__device__ __forceinline__ int pi32(int r) { return 16 * (r >> 4) + 8 * ((r >> 2) & 1) + 4 * ((r >> 3) & 1) + (r & 3); }
__device__ __forceinline__ void ssd_scan_phase(const Params& P, LAS unsigned char* lds, int layer_j, bf16_t* Gout, float* SSG) {
  constexpr int RS = 136;
  LAS bf16_t* Bs = (LAS bf16_t*)lds;
  LAS bf16_t* BwT = Bs + 128 * RS;
  LAS bf16_t* Cs = BwT + 128 * RS;
  LAS bf16_t* XT = Cs + 128 * RS;
  LAS bf16_t* St = XT + 64 * RS;
  LAS float* acum = (LAS float*)(St + 64 * RS);
  LAS float* dts = acum + 128;
  LAS float* wdec = dts + 128;
  LAS float* eacum = wdec + 128;
  LAS float* cfac = eacum + 128;
  const bf16_t* XBC = (const bf16_t*)(P.ws + WS_XBC); const bf16_t* Z = (const bf16_t*)(P.ws + WS_Z); const float* DT = (const float*)(P.ws + WS_DT);
  int tid0 = threadIdx.x; asm volatile("" : "+v"(tid0));
  const int wid = __builtin_amdgcn_readfirstlane(tid0 >> 6);
  const int tb = wid >> 1, pb = wid & 1;
#define SCAN_LANE() int tid = tid0; asm volatile("" : "+v"(tid)); const int lane = tid & 63, l32 = lane & 31, hh = lane >> 5; (void)l32; (void)hh
  for (int item = blockIdx.x; item < 256; item += gridDim.x) {
    const int b = item >> 5, hd = item & 31, grp = hd >> 2;
    const float Aneg = -__expf(P.ssd_a_log[layer_j * SSD_H + hd]), Dh = P.ssd_d[layer_j * SSD_H + hd];
    f32x16 st;
#pragma unroll
    for (int i = 0; i < 16; ++i) st[i] = 0.f;
    for (int e = tid0; e < 64 * RS / 2; e += NTHREADS) ((LAS unsigned*)St)[e] = 0u;
    const unsigned vo_bc0 = (unsigned)(tid0 >> 4) * 8192u + (unsigned)(2048 + grp * 128 + (tid0 & 15) * 8) * 2u;
    const unsigned vo_colb = (unsigned)(hd * 64 + 32 * pb + 8 * (tid0 & 3)) * 2u, vo_row = (unsigned)(32 * tb + ((tid0 & 63) >> 2));
    const unsigned vo_xq0 = vo_row * 8192u + vo_colb, vo_zq0 = vo_row * 4096u + vo_colb;
    const char* xbc_b = (const char*)XBC + (size_t)b * SEQ * 8192; const char* z_b = (const char*)Z + (size_t)b * SEQ * 4096; char* g_b = (char*)Gout + (size_t)b * SEQ * 4096;
    u32x4 vb[4], vc[4], xq[2], zq[2], xqn[2], zqn[2]; float d0 = 0.f, d1 = 0.f; float ssq_prev[2] = {0.f, 0.f};
#define SCAN_LOADS(T0, XQ, ZQ) do { const char* cb_ = xbc_b + (size_t)(T0) * 8192; const char* zb_ = z_b + (size_t)(T0) * 4096; unsigned vo_bc = vo_bc0, vo_xq = vo_xq0, vo_zq = vo_zq0; asm volatile("" : "+v"(vo_bc), "+v"(vo_xq), "+v"(vo_zq)); \
      d0 = DT[(size_t)(b * SEQ + (T0) + 2 * (tid0 & 63)) * SSD_H + hd]; d1 = DT[(size_t)(b * SEQ + (T0) + 2 * (tid0 & 63) + 1) * SSD_H + hd];     \
      _Pragma("unroll") for (int k = 0; k < 4; ++k) { vb[k] = *(const u32x4*)(cb_ + (size_t)(32 * k) * 8192 + vo_bc); vc[k] = *(const u32x4*)(cb_ + (size_t)(32 * k) * 8192 + 2048 + vo_bc); } \
      _Pragma("unroll") for (int k = 0; k < 2; ++k) { XQ[k] = *(const u32x4*)(cb_ + (size_t)(16 * k) * 8192 + vo_xq); ZQ[k] = *(const u32x4*)(zb_ + (size_t)(16 * k) * 4096 + vo_zq); } \
      } while (0)
    SCAN_LOADS(0, xq, zq);
    __builtin_amdgcn_s_waitcnt(0x0F70);
    for (int c = 0; c < 32; ++c) {
      const int t0 = b * SEQ + 128 * c;
      {
      { SCAN_LANE();
#pragma unroll
      for (int k = 0; k < 4; ++k) { const int s = (tid >> 4) + 32 * k, n8 = tid & 15; *(LAS u32x4*)(Bs + s * RS + n8 * 8) = vb[k]; *(LAS u32x4*)(Cs + s * RS + n8 * 8) = vc[k]; }
      if (wid == 0) {
        const int s0 = 2 * lane; const float a0 = Aneg * d0, a1 = Aneg * d1; float s = a0 + a1;
#pragma unroll
        for (int o = 1; o < 64; o <<= 1) { const float v = __shfl_up(s, o); if (lane >= o) s += v; }
        const float tot = __shfl(s, 63), bend = __shfl(s, (lane & ~15) | 15), c0 = s - a1;
        acum[s0] = c0; acum[s0 + 1] = s; dts[s0] = d0; dts[s0 + 1] = d1;
        wdec[s0] = __expf(tot - c0); wdec[s0 + 1] = __expf(tot - s); eacum[s0] = __expf(c0); eacum[s0 + 1] = __expf(s);
        cfac[s0] = __expf(bend - c0); cfac[s0 + 1] = __expf(bend - s);
      } }
      __syncthreads();
      { SCAN_LANE();
#pragma unroll
      for (int k = 0; k < 2; ++k) { const int s = 32 * tb + (lane >> 2) + 16 * k, p0 = 32 * pb + 8 * (lane & 3); const float dv = dts[s];
#pragma unroll
        for (int e = 0; e < 4; ++e) { XT[(p0 + 2 * e) * RS + s] = f2bf(bflo(xq[k][e]) * dv); XT[(p0 + 2 * e + 1) * RS + s] = f2bf(bfhi(xq[k][e]) * dv); } }
#pragma unroll
      for (int k = 0; k < 4; ++k) { const int id = tid + NTHREADS * k, n = id & 127, s8 = id >> 7; float bv[8];
#pragma unroll
        for (int j = 0; j < 8; ++j) bv[j] = bf2f(Bs[(8 * s8 + j) * RS + n]) * wdec[8 * s8 + j];
        u32x4 w; w.x = cvtpk(bv[0], bv[1]); w.y = cvtpk(bv[2], bv[3]); w.z = cvtpk(bv[4], bv[5]); w.w = cvtpk(bv[6], bv[7]);
        *(LAS u32x4*)(BwT + n * RS + 8 * s8) = w; } }
      __syncthreads();
      }
      if (c > 0) { SCAN_LANE(); if ((lane & 3) == 0) { float* sp = SSG + (t0 - 128) + 32 * tb + (lane >> 2); atomicAdd((int*)sp, ss_q(ssq_prev[0])); atomicAdd((int*)sp + 16, ss_q(ssq_prev[1])); } }
      if (c + 1 < 32) SCAN_LOADS(128 * (c + 1), xqn, zqn);
      f32x16 y;
      { SCAN_LANE();
#pragma unroll
      for (int i = 0; i < 16; ++i) y[i] = 0.f;
      bf16x8 cf[8];
      { const LAS bf16_t* cp = Cs + (32 * tb + l32) * RS + 8 * hh;
#pragma unroll
        for (int kk = 0; kk < 8; ++kk) cf[kk] = *(const LAS bf16x8*)(cp + 16 * kk); }
      { const LAS bf16_t* bp = St + (32 * pb + l32) * RS + 8 * hh;
        const int pt = wid & 1, nt = wid >> 1; const float dl = eacum[127];
#pragma unroll
        for (int i = 0; i < 16; ++i) st[i] *= dl;
        const LAS bf16_t* ap2 = XT + (32 * pt + l32) * RS + 8 * hh; const LAS bf16_t* bp2 = BwT + (32 * nt + l32) * RS + 8 * hh;
#pragma unroll
        for (int kk = 0; kk < 8; ++kk) { y = mfma32(cf[kk], *(const LAS bf16x8*)(bp + 16 * kk), y); st = mfma32(*(const LAS bf16x8*)(ap2 + 16 * kk), *(const LAS bf16x8*)(bp2 + 16 * kk), st); } }
#pragma unroll
      for (int i = 0; i < 16; ++i) y[i] *= eacum[32 * tb + 8 * (i >> 2) + 4 * hh + (i & 3)];
      const float at = acum[32 * tb + l32];
      f32x16 S0, S1;
#define SCAN_CB(SB) do { _Pragma("unroll") for (int i = 0; i < 16; ++i) { S0[i] = 0.f; S1[i] = 0.f; } \
        const LAS bf16_t* ap_ = Bs + (32 * (SB) + pi32(l32)) * RS + 8 * hh; \
        _Pragma("unroll") for (int kk = 0; kk < 8; kk += 2) { S0 = mfma32(*(const LAS bf16x8*)(ap_ + 16 * kk), cf[kk], S0); S1 = mfma32(*(const LAS bf16x8*)(ap_ + 16 * kk + 16), cf[kk + 1], S1); } } while (0)
      SCAN_CB(0);
      for (int sb = 0; sb <= tb; ++sb) {
        float sv[16];
#pragma unroll
        for (int i = 0; i < 16; ++i) sv[i] = S0[i] + S1[i];
        if (sb < tb) SCAN_CB(sb + 1);
        float pv[16];
        if (sb < tb) {
          const float rowf = __expf(at - acum[32 * sb + 31]);
#pragma unroll
          for (int i = 0; i < 16; ++i) pv[i] = sv[i] * (rowf * cfac[32 * sb + 16 * (i >> 3) + 8 * hh + (i & 7)]);
        } else {
#pragma unroll
          for (int i = 0; i < 16; ++i) { const int sl = 16 * (i >> 3) + 8 * hh + (i & 7); const float dec = __expf(at - acum[32 * sb + sl]); pv[i] = (sl <= l32) ? sv[i] * dec : 0.f; }
        }
        u32x4 p0, p1; p0.x = cvtpk(pv[0], pv[1]); p0.y = cvtpk(pv[2], pv[3]); p0.z = cvtpk(pv[4], pv[5]); p0.w = cvtpk(pv[6], pv[7]);
        p1.x = cvtpk(pv[8], pv[9]); p1.y = cvtpk(pv[10], pv[11]); p1.z = cvtpk(pv[12], pv[13]); p1.w = cvtpk(pv[14], pv[15]);
        const LAS bf16_t* xb = XT + (32 * pb + l32) * RS + 32 * sb + 8 * hh;
        y = mfma32(__builtin_bit_cast(bf16x8, p0), *(const LAS bf16x8*)(xb), y);
        y = mfma32(__builtin_bit_cast(bf16x8, p1), *(const LAS bf16x8*)(xb + 16), y);
      }
#undef SCAN_CB
      }
      __syncthreads();
      { SCAN_LANE();
      { const int pt = wid & 1, nt = wid >> 1;
#pragma unroll
        for (int i = 0; i < 16; ++i) St[(32 * pt + 8 * (i >> 2) + 4 * hh + (i & 3)) * RS + 32 * nt + l32] = f2bf(st[i]); }
      LAS float* ys = (LAS float*)BwT + wid * (32 * 34);
#pragma unroll
      for (int i = 0; i < 16; ++i) ys[(8 * (i >> 2) + 4 * hh + (i & 3)) * 34 + l32] = y[i];
      asm volatile("s_waitcnt lgkmcnt(0)" ::: "memory");
      char* gb_ = g_b + (size_t)(128 * c) * 4096; unsigned vo_zq = vo_zq0; asm volatile("" : "+v"(vo_zq));
#pragma unroll
      for (int k = 0; k < 2; ++k) { const int row = (lane >> 2) + 16 * k; const LAS f32x2_t* yp = (const LAS f32x2_t*)(ys + row * 34 + 8 * (lane & 3));
        float yv[8];
#pragma unroll
        for (int e = 0; e < 4; ++e) { const f32x2_t t2 = yp[e]; yv[2 * e] = t2.x; yv[2 * e + 1] = t2.y; }
        float gv[8]; float ssq = 0.f;
#pragma unroll
        for (int e = 0; e < 4; ++e) { gv[2 * e] = (yv[2 * e] + Dh * bflo(xq[k][e])) * silu_f(bflo(zq[k][e])); gv[2 * e + 1] = (yv[2 * e + 1] + Dh * bfhi(xq[k][e])) * silu_f(bfhi(zq[k][e]));
          ssq += gv[2 * e] * gv[2 * e] + gv[2 * e + 1] * gv[2 * e + 1]; }
        u32x4 w; w.x = cvtpk(gv[0], gv[1]); w.y = cvtpk(gv[2], gv[3]); w.z = cvtpk(gv[4], gv[5]); w.w = cvtpk(gv[6], gv[7]);
        *(u32x4*)(gb_ + (size_t)(16 * k) * 4096 + vo_zq) = w;
        ssq += __shfl_xor(ssq, 1); ssq += __shfl_xor(ssq, 2);
        ssq_prev[k] = ssq; }
      }
#pragma unroll
      for (int k = 0; k < 2; ++k) { xq[k] = xqn[k]; zq[k] = zqn[k]; }
    }
    { SCAN_LANE(); if ((lane & 3) == 0) { float* sp = SSG + (b * SEQ + 128 * 31) + 32 * tb + (lane >> 2); atomicAdd((int*)sp, ss_q(ssq_prev[0])); atomicAdd((int*)sp + 16, ss_q(ssq_prev[1])); } }
#undef SCAN_LOADS
#undef SCAN_LANE
    __syncthreads();
  }
}

__device__ __forceinline__ void sb_attn_phase(const Params& P) {
  const bf16_t* Q = (const bf16_t*)(P.ws + WS_Q); const bf16_t* Kb = (const bf16_t*)(P.ws + WS_K); const bf16_t* Vt = (const bf16_t*)(P.ws + WS_VT); bf16_t* O = (bf16_t*)(P.ws + WS_O);
  int tid = threadIdx.x; asm volatile("" : "+v"(tid));
  const int lane = tid & 63, wid = __builtin_amdgcn_readfirstlane(tid >> 6), l32 = lane & 31, hh = lane >> 5;
  const int gw = blockIdx.x * 8 + wid, ngw = gridDim.x * 8;
  for (int item = gw; item < 8 * 16 * 128; item += ngw) {
    const int qt = 127 - (item >> 7), bh = item & 127, b = bh >> 4, h = bh & 15;
    const int q0 = 32 * qt; const size_t rowbase = (size_t)b * SEQ;
    bf16x8 qf[4];
#pragma unroll
    for (int d0 = 0; d0 < 4; ++d0) qf[d0] = *(const bf16x8*)(Q + (rowbase + q0 + l32) * DM + h * 64 + 16 * d0 + 8 * hh);
    f32x16 o0, o1;
#pragma unroll
    for (int i = 0; i < 16; ++i) { o0[i] = 0.f; o1[i] = 0.f; }
    float R = 0.f;
    const bf16_t* vbase = Vt + ((size_t)(bh * 64 + l32)) * SEQ + 8 * hh;
    const bf16_t* kbase = Kb + (rowbase + pi32(l32)) * DM + h * 64 + 8 * hh;
    bf16x8 kn[4];
#pragma unroll
    for (int d0 = 0; d0 < 4; ++d0) kn[d0] = *(const bf16x8*)(kbase + (size_t)q0 * DM + 16 * d0);
    for (int kb = q0; kb >= 0; kb -= 32) {
      f32x16 S;
#pragma unroll
      for (int i = 0; i < 16; ++i) S[i] = 0.f;
      bf16x8 kf[4], vf[4];
#pragma unroll
      for (int d0 = 0; d0 < 4; ++d0) kf[d0] = kn[d0];
      { const bf16_t* vp = vbase + kb;
        vf[0] = *(const bf16x8*)(vp); vf[1] = *(const bf16x8*)(vp + 16); vf[2] = *(const bf16x8*)(vp + 32 * SEQ); vf[3] = *(const bf16x8*)(vp + 32 * SEQ + 16); }
      if (kb >= 32) {
#pragma unroll
        for (int d0 = 0; d0 < 4; ++d0) kn[d0] = *(const bf16x8*)(kbase + (size_t)(kb - 32) * DM + 16 * d0); }
#pragma unroll
      for (int d0 = 0; d0 < 4; ++d0) S = mfma32(kf[d0], qf[d0], S);
      float lb[16], lf[16]; float g0 = 0.f, g1 = 0.f;
#pragma unroll
      for (int i = 0; i < 16; ++i) { const float L = S[i]; const int kl = 16 * (i >> 3) + 8 * hh + (i & 7); const bool ok = (kb < q0) || (kl < l32);
        const float sp = __logf(1.f + __expf(-fabsf(L)));
        lb[i] = fminf(L, 0.f) - sp; const float f = ok ? (lb[i] - L) : 0.f; lf[i] = f; if (i < 8) g0 += f; else g1 += f;
        if (!ok) lb[i] = -1e30f; }
      const float h0 = __shfl_xor(g0, 32), h1 = __shfl_xor(g1, 32);
      const float after0 = hh == 0 ? (h0 + g1 + h1) : (h1 + g1);
      const float after1 = hh == 0 ? h1 : 0.f;
      float pw[16]; float run = after0 + R;
#pragma unroll
      for (int i = 7; i >= 0; --i) { pw[i] = __expf(lb[i] + run); run += lf[i]; }
      run = after1 + R;
#pragma unroll
      for (int i = 15; i >= 8; --i) { pw[i] = __expf(lb[i] + run); run += lf[i]; }
      R += (g0 + g1) + (h0 + h1);
      u32x4 p0, p1; p0.x = cvtpk(pw[0], pw[1]); p0.y = cvtpk(pw[2], pw[3]); p0.z = cvtpk(pw[4], pw[5]); p0.w = cvtpk(pw[6], pw[7]);
      p1.x = cvtpk(pw[8], pw[9]); p1.y = cvtpk(pw[10], pw[11]); p1.z = cvtpk(pw[12], pw[13]); p1.w = cvtpk(pw[14], pw[15]);
      o0 = mfma32(__builtin_bit_cast(bf16x8, p0), vf[0], o0);
      o0 = mfma32(__builtin_bit_cast(bf16x8, p1), vf[1], o0);
      o1 = mfma32(__builtin_bit_cast(bf16x8, p0), vf[2], o1);
      o1 = mfma32(__builtin_bit_cast(bf16x8, p1), vf[3], o1);
      if (__all(R < -104.f)) break;
    }
#pragma unroll
    for (int i = 0; i < 16; ++i) { bf16_t* op = O + (rowbase + q0 + 8 * (i >> 2) + 4 * hh + (i & 3)) * DM + h * 64 + l32; op[0] = f2bf(o0[i]); op[32] = f2bf(o1[i]); }
  }
}

struct WaveId { int lane, wid, gw, ngw; };
__device__ __forceinline__ WaveId wave_id() { int tid = threadIdx.x; asm volatile("" : "+v"(tid)); WaveId w; w.lane = tid & 63; w.wid = __builtin_amdgcn_readfirstlane(tid >> 6); w.gw = blockIdx.x * 8 + w.wid; w.ngw = gridDim.x * 8; return w; }
__device__ __forceinline__ void prologue_phase(const float* x, bf16_t* XB, float* ss0) { const WaveId w = wave_id();
  for (int m = w.gw; m < T; m += w.ngw) { const f32x4* xr = (const f32x4*)(x + (size_t)m * DM) + w.lane; u32x2* hrow = (u32x2*)(XB + (size_t)m * DM); float s = 0.f;
#pragma unroll
    for (int j = 0; j < 4; ++j) { const f32x4 v = xr[64 * j]; s += (v.x * v.x + v.y * v.y) + (v.z * v.z + v.w * v.w); u32x2 h; h.x = cvtpk(v.x, v.y); h.y = cvtpk(v.z, v.w); hrow[w.lane + 64 * j] = h; }
    s = wave_sum(s); if (w.lane == 0) ((int*)ss0)[m] = ss_q(s); } }
__device__ __forceinline__ void final_norm_phase(const bf16_t* XB, float* out, const float* g, const float* ss) { const WaveId w = wave_id();
  for (int m = w.gw; m < T; m += w.ngw) { const u32x2* hrow = (const u32x2*)(XB + (size_t)m * DM); f32x4* orow = (f32x4*)(out + (size_t)m * DM) + w.lane;
    const f32x4* gr = (const f32x4*)g + w.lane; const float rstd = rsqrtf(ss_f(ss[m]) * (1.f / DM) + EPS);
#pragma unroll
    for (int j = 0; j < 4; ++j) { const u32x2 h = hrow[w.lane + 64 * j]; const f32x4 v = {bflo(h.x), bfhi(h.x), bflo(h.y), bfhi(h.y)}; orow[64 * j] = v * rstd * gr[64 * j]; } } }
__device__ __forceinline__ void zero_phase(float* a, float* b) { int tid = threadIdx.x; asm volatile("" : "+v"(tid));
  for (int i = blockIdx.x * NTHREADS + tid; i < T; i += gridDim.x * NTHREADS) { a[i] = 0.f; if (b) b[i] = 0.f; } }
__device__ __forceinline__ void convert_phase(const float* W, const float* gk, int K, int N, bf16_t* WT, int kind, LAS unsigned char* lds, int& cum) { const WaveId w = wave_id();
  const int rot = cum % w.ngw, first = w.gw >= rot ? w.gw - rot : w.gw + w.ngw - rot;
  convert_weight(W, gk, K, N, WT, kind, (LAS float*)(lds + w.wid * 16384), first, w.ngw, w.lane); cum += (K / 64) * (N / 32); }
__device__ __forceinline__ void convert_mixer(const Params& P, int layer, bf16_t* Wmi, bf16_t* Wmo, LAS unsigned char* lds, int& cum) {
  const int j = layer >> 1;
  if ((layer & 1) == 0) {
    convert_phase(P.ssd_w_in + (size_t)j * DM * SSD_IN, P.mix_norm + layer * DM, DM, SSD_IN, Wmi, 0, lds, cum);
    convert_phase(P.ssd_w_out + (size_t)j * SSD_DI * DM, P.ssd_norm + j * SSD_DI, SSD_DI, DM, Wmo, 0, lds, cum);
  } else {
    convert_phase(P.sb_w_qkv + (size_t)j * DM * 3 * DM, P.mix_norm + layer * DM, DM, 3 * DM, Wmi, 0, lds, cum);
    convert_phase(P.sb_w_out + (size_t)j * DM * DM, nullptr, DM, DM, Wmo, 0, lds, cum);
  }
}

__device__ __forceinline__ void ffn_fixup_tile(int pm, const float* PB, const float* UB, const float* cw, bf16_t* A) {
  if (pm == 0 || (pm & 15) == 0) return;
  int tid = threadIdx.x; asm volatile("" : "+v"(tid));
  for (int it = tid; it < 2 * (FF / 4); it += NTHREADS) {
    const int q = it % (FF / 4), r = it / (FF / 4), c = 4 * q;
    const float* pb = PB + ((size_t)pm * 2 + r) * (2 * FF) + c; const float* ub = UB + ((size_t)(pm - 1) * 2) * (2 * FF) + c;
    f32x4 g = *(const f32x4*)pb, uu = *(const f32x4*)(pb + FF);
    const f32x4 g0 = *(const f32x4*)(cw + c), g1 = *(const f32x4*)(cw + 2 * FF + c), u0 = *(const f32x4*)(cw + FF + c), u1 = *(const f32x4*)(cw + 3 * FF + c);
    const f32x4 pg254 = *(const f32x4*)ub, pu254 = *(const f32x4*)(ub + FF), pg255 = *(const f32x4*)(ub + 2 * FF), pu255 = *(const f32x4*)(ub + 3 * FF);
    if (r == 0) { g += g1 * pg255 + g0 * pg254; uu += u1 * pu255 + u0 * pu254; }
    else        { g += g0 * pg255;              uu += u0 * pu255; }
    u32x2 w; w.x = cvtpk(silu_f(g[0]) * uu[0], silu_f(g[1]) * uu[1]); w.y = cvtpk(silu_f(g[2]) * uu[2], silu_f(g[3]) * uu[3]);
    *(u32x2*)(A + (size_t)(pm * 256 + r) * FF + c) = w;
  }
}

__global__ void __launch_bounds__(NTHREADS, 2) fwd_megakernel(Params P) {
  extern __shared__ __attribute__((aligned(16))) unsigned char lds_raw[];
  LAS unsigned char* lds = (LAS unsigned char*)lds_raw;
  cg::grid_group grid = cg::this_grid();
  const int G = gridDim.x;
  unsigned char* ws = P.ws;
  bf16_t* Wmi = (bf16_t*)(ws + WS_WMI); bf16_t* Wmo = (bf16_t*)(ws + WS_WMO); bf16_t* Wfi = (bf16_t*)(ws + WS_WFI); bf16_t* Wfo = (bf16_t*)(ws + WS_WFO);
  bf16_t* H = (bf16_t*)(ws + WS_H);
  float* SS0 = (float*)(ws + WS_SS0); float* SS1 = (float*)(ws + WS_SS1); float* SSG = (float*)(ws + WS_SSG);
  LAS float* carry = (LAS float*)(lds + RING_BYTES);
  LAS float* rtab = (LAS float*)(lds + RING_BYTES + 12288);
  LAS float* wtab = (LAS float*)(lds + RING_BYTES + 13312);
  volatile LAS unsigned* bst = (volatile LAS unsigned*)(lds + LDS_BYTES - 64);
  if (threadIdx.x < 2) bst[threadIdx.x] = 0u;
  __syncthreads();
  const XcdBarrier bar = xcd_barrier_post((unsigned*)(ws + WS_BAR), bst);
#define GSYNC() xcd_barrier(bar)

  prologue_phase(P.x, H, SS0);
  zero_phase(SS1, SSG);
  { int cum = 0; convert_mixer(P, 0, Wmi, Wmo, lds, cum);
    convert_phase(P.ffn_w_in, P.ffn_norm, DM, 2 * FF, Wfi, 1, lds, cum);
    convert_phase(P.ffn_w_out, nullptr, FF, DM, Wfo, 0, lds, cum); }
  GSYNC();
  if (G == 0x7fffffff) grid.sync();

  for (int layer = 0; layer < 4; ++layer) {
    const int j = layer >> 1; const bool is_ssd = (layer & 1) == 0;
    if (layer > 0) zero_phase(SS1, nullptr);
    if (is_ssd) {
      { pg8::Gemm g{H, Wmi, 130, 25, DM, 253, -3}; pg8::StaticOrder S; S.init(130, 25, G, blockIdx.x);
        pg8::EpiSsdIn E{(bf16_t*)(ws + WS_Z), (bf16_t*)(ws + WS_XBC), (float*)(ws + WS_DT), P.ssd_conv_w + (size_t)j * 4 * SSD_CONVD, P.ssd_conv_b + (size_t)j * SSD_CONVD, P.ssd_dt_bias + j * SSD_H, {carry}, SS0, rtab, wtab};
        pg8::gemm_phase(lds, g, S, E); }
      GSYNC();
      ssd_scan_phase(P, lds, j, (bf16_t*)(ws + WS_Z), SSG);
      if (layer > 0) { int cum = 0; convert_phase(P.ffn_w_out + (size_t)layer * FF * DM, nullptr, FF, DM, Wfo, 0, lds, cum); }
      GSYNC();
      { pg8::Gemm g{(const bf16_t*)(ws + WS_Z), Wmo, 128, 4, SSD_DI, 256, 0}; pg8::StaticOrder S; S.init(128, 4, G, blockIdx.x);
        pg8::EpiRes E{H, SS1, SSG, rtab}; pg8::gemm_phase(lds, g, S, E); }
      GSYNC();
    } else {
      { pg8::Gemm g{H, Wmi, 128, 12, DM, 256, 0}; pg8::StaticOrder S; S.init(128, 12, G, blockIdx.x);
        pg8::EpiQkv E{(bf16_t*)(ws + WS_Q), (bf16_t*)(ws + WS_K), (bf16_t*)(ws + WS_VT), SS0, rtab}; pg8::gemm_phase(lds, g, S, E); }
      GSYNC();
      sb_attn_phase(P);
      { int cum = 0; convert_phase(P.ffn_w_out + (size_t)layer * FF * DM, nullptr, FF, DM, Wfo, 0, lds, cum); }
      GSYNC();
      { pg8::Gemm g{(const bf16_t*)(ws + WS_O), Wmo, 128, 4, DM, 256, 0}; pg8::StaticOrder S; S.init(128, 4, G, blockIdx.x);
        pg8::EpiRes E{H, SS1, nullptr, rtab}; pg8::gemm_phase(lds, g, S, E); }
      GSYNC();
    }
    zero_phase(SS0, SSG);
    { pg8::Gemm g{H, Wfi, 128, 22, DM, 256, 0}; pg8::StaticOrder S; S.init(128, 22, G, blockIdx.x);
      pg8::EpiFfnIn E{(bf16_t*)(ws + WS_A), P.ffn_conv_w + (size_t)layer * 3 * 2 * FF, P.ffn_conv_b + (size_t)layer * 2 * FF, {carry}, SS1, rtab, wtab, (float*)(ws + WS_PB), (float*)(ws + WS_UB)}; pg8::gemm_phase(lds, g, S, E); }
    GSYNC();
    { pg8::Gemm g{(const bf16_t*)(ws + WS_A), Wfo, 128, 4, FF, 256, 0}; pg8::StaticOrder S; S.init(128, 4, G, blockIdx.x);
      { pg8::Unit fu; for (int i = 0; S.next(i, fu); ++i) ffn_fixup_tile(fu.pm, (const float*)(ws + WS_PB), (const float*)(ws + WS_UB), P.ffn_conv_w + (size_t)layer * 3 * 2 * FF, (bf16_t*)(ws + WS_A));
        asm volatile("s_waitcnt vmcnt(0)" ::: "memory"); __syncthreads(); }
      pg8::EpiRes E{H, SS0, nullptr, rtab}; pg8::gemm_phase(lds, g, S, E); }
    if (layer < 3) {
      int cum = 0; convert_mixer(P, layer + 1, Wmi, Wmo, lds, cum);
      convert_phase(P.ffn_w_in + (size_t)(layer + 1) * DM * 2 * FF, P.ffn_norm + (layer + 1) * DM, DM, 2 * FF, Wfi, 1, lds, cum);
    }
    GSYNC();
  }
  final_norm_phase(H, P.out, P.final_norm, SS0);
}

extern "C" void kernel_launch(void* const* d_in, const int* in_sizes, int n_in, void* d_out, int out_size, void* d_ws, size_t ws_size, hipStream_t stream) {
  static int grid_blocks = 0;
  if (!grid_blocks) {
    if (n_in != 18 || out_size != T * DM || ws_size < WS_END) { fprintf(stderr, "kernel_launch: unexpected shapes (n_in %d out %d ws %zu)\n", n_in, out_size, ws_size); grid_blocks = -1; return; }
    int dev = 0, cus = 0, per_cu = 0;
    (void)hipGetDevice(&dev);
    (void)hipDeviceGetAttribute(&cus, hipDeviceAttributeMultiprocessorCount, dev);
    (void)hipFuncSetAttribute((const void*)fwd_megakernel, hipFuncAttributeMaxDynamicSharedMemorySize, LDS_BYTES);
    (void)hipOccupancyMaxActiveBlocksPerMultiprocessor(&per_cu, (const void*)fwd_megakernel, NTHREADS, LDS_BYTES);
    if (per_cu < 1) per_cu = 1;
    grid_blocks = cus * per_cu;
  }
  if (grid_blocks < 0) return;
  Params p{};
  p.x = (const float*)d_in[0]; p.mix_norm = (const float*)d_in[1]; p.ffn_norm = (const float*)d_in[2]; p.final_norm = (const float*)d_in[3];
  p.ssd_w_in = (const float*)d_in[4]; p.ssd_conv_w = (const float*)d_in[5]; p.ssd_conv_b = (const float*)d_in[6]; p.ssd_dt_bias = (const float*)d_in[7];
  p.ssd_a_log = (const float*)d_in[8]; p.ssd_d = (const float*)d_in[9]; p.ssd_norm = (const float*)d_in[10]; p.ssd_w_out = (const float*)d_in[11];
  p.sb_w_qkv = (const float*)d_in[12]; p.sb_w_out = (const float*)d_in[13]; p.ffn_w_in = (const float*)d_in[14]; p.ffn_conv_w = (const float*)d_in[15];
  p.ffn_conv_b = (const float*)d_in[16]; p.ffn_w_out = (const float*)d_in[17];
  p.out = (float*)d_out; p.ws = (unsigned char*)d_ws;
  (void)hipMemsetAsync((char*)d_ws + WS_BAR, 0, 65536, stream);
  void* args[] = {&p};
  hipError_t e = hipLaunchCooperativeKernel((const void*)fwd_megakernel, dim3(grid_blocks), dim3(NTHREADS), args, LDS_BYTES, stream);
  if (e != hipSuccess) fprintf(stderr, "cooperative launch failed: %s (grid %d)\n", hipGetErrorString(e), grid_blocks);
}
```

```cpp
#include <hip/hip_runtime.h>
#include <hip/hip_cooperative_groups.h>
#include <cstdio>
#include <cstdint>
namespace cg = cooperative_groups;

#define LAS __attribute__((address_space(3)))
typedef unsigned short bf16_t;
typedef short bf16x8 __attribute__((ext_vector_type(8)));
typedef float f32x4 __attribute__((ext_vector_type(4)));
typedef float f32x16 __attribute__((ext_vector_type(16)));
typedef unsigned u32x4 __attribute__((ext_vector_type(4)));
typedef unsigned u32x2 __attribute__((ext_vector_type(2)));
typedef float f32x2_t __attribute__((ext_vector_type(2)));
typedef __bf16 bf16x2_t __attribute__((ext_vector_type(2)));

constexpr int T = 32768, SEQ = 4096, DM = 1024;
constexpr int SSD_DI = 2048, SSD_CONVD = 4096, SSD_IN = 6176, SSD_H = 32;
constexpr int FF = 2816;
constexpr float EPS = 1e-6f;
constexpr int NTHREADS = 512;

constexpr size_t MiB = 1u << 20;
constexpr size_t WS_BAR = 0;
constexpr size_t WS_SS0 = 128 * 1024;
constexpr size_t WS_SS1 = 384 * 1024;
constexpr size_t WS_SSG = 640 * 1024;
constexpr size_t WS_WMI = 1 * MiB;
constexpr size_t WS_WMO = 14 * MiB;
constexpr size_t WS_WFI = 18 * MiB;
constexpr size_t WS_WFO = 30 * MiB;
constexpr size_t WS_H   = 37 * MiB;
constexpr size_t WS_ACT = 102 * MiB;
constexpr size_t WS_Z   = WS_ACT;
constexpr size_t WS_XBC = WS_ACT + 128 * MiB;
constexpr size_t WS_DT  = WS_ACT + 384 * MiB;
constexpr size_t WS_Q   = WS_ACT;
constexpr size_t WS_K   = WS_ACT + 64 * MiB;
constexpr size_t WS_VT  = WS_ACT + 128 * MiB;
constexpr size_t WS_O   = WS_ACT + 192 * MiB;
constexpr size_t WS_A   = WS_ACT;
constexpr size_t WS_PB  = WS_ACT + 200 * MiB;
constexpr size_t WS_UB  = WS_ACT + 208 * MiB;
constexpr size_t WS_END = WS_ACT + 388 * MiB;

constexpr int LDS_BYTES = 151552;
constexpr int RING_BYTES = 131072;

struct Params {
  const float* x; const float* mix_norm; const float* ffn_norm; const float* final_norm;
  const float* ssd_w_in; const float* ssd_conv_w; const float* ssd_conv_b; const float* ssd_dt_bias; const float* ssd_a_log; const float* ssd_d;
  const float* ssd_norm; const float* ssd_w_out; const float* sb_w_qkv; const float* sb_w_out;
  const float* ffn_w_in; const float* ffn_conv_w; const float* ffn_conv_b; const float* ffn_w_out;
  float* out; unsigned char* ws;
};

__device__ __forceinline__ unsigned cvtpk(float lo, float hi) { f32x2_t v = {lo, hi}; bf16x2_t b = __builtin_convertvector(v, bf16x2_t); return __builtin_bit_cast(unsigned, b); }
__device__ __forceinline__ bf16_t f2bf(float f) { return (bf16_t)(cvtpk(f, 0.f) & 0xffffu); }
__device__ __forceinline__ float bf2f(bf16_t h) { return __uint_as_float((unsigned)h << 16); }
__device__ __forceinline__ float bflo(unsigned w) { return __uint_as_float(w << 16); }
__device__ __forceinline__ float bfhi(unsigned w) { return __uint_as_float(w & 0xffff0000u); }
constexpr float SS_SCALE = 4096.f, SS_INV = 1.f / 4096.f;
__device__ __forceinline__ int ss_q(float s) { return __float2int_rn(fminf(s * SS_SCALE, 1.0e9f)); }
__device__ __forceinline__ float ss_f(float raw_bits) { return (float)__float_as_int(raw_bits) * SS_INV; }
__device__ __forceinline__ float silu_f(float x) { return x * __builtin_amdgcn_rcpf(1.f + __expf(-x)); }
__device__ __forceinline__ float wave_sum(float v) {
#pragma unroll
  for (int o = 1; o < 64; o <<= 1) v += __shfl_xor(v, o);
  return v;
}
template <int D> __device__ __forceinline__ float rot16(float v) {
  return __int_as_float(__builtin_amdgcn_update_dpp(0, __float_as_int(v), 0x120 + D, 0xf, 0xf, false));
}
template <int D> __device__ __forceinline__ f32x4 rot16x4(f32x4 v) { f32x4 r; r[0] = rot16<D>(v[0]); r[1] = rot16<D>(v[1]); r[2] = rot16<D>(v[2]); r[3] = rot16<D>(v[3]); return r; }
__device__ __forceinline__ f32x16 mfma32(bf16x8 a, bf16x8 b, f32x16 c) { return __builtin_amdgcn_mfma_f32_32x32x16_bf16(a, b, c, 0, 0, 0); }


#define XB_TMO      128
#define XB_XCNT(j)  (256  + 64 * (j))
#define XB_XSUB(j)  (1280 + 64 * (j))
#define XB_XGEN(j)  (2304 + 64 * (j))
#define XB_TOP      3328
#define XB_TOPGEN   3392
#define XCD_BAR_WORDS 3456
#define XB_SPIN_CAP (1u << 18)
__device__ __forceinline__ unsigned xb_ld(unsigned* p)              { return __hip_atomic_load(p, __ATOMIC_RELAXED, __HIP_MEMORY_SCOPE_AGENT); }
__device__ __forceinline__ unsigned xb_add(unsigned* p, unsigned v) { return __hip_atomic_fetch_add(p, v, __ATOMIC_RELAXED, __HIP_MEMORY_SCOPE_AGENT); }
__device__ __forceinline__ unsigned xb_xcc_id() { return (unsigned)__builtin_amdgcn_s_getreg((3 << 11) | 20) & 0xFu; }
#define XB_SPIN(cond, bar) do { unsigned _sp = 0; while (cond) { __builtin_amdgcn_s_sleep(1); \
    if ((++_sp & 255u) == 0u) { if (xb_ld(&(bar)[XB_TMO])) break; if (_sp > XB_SPIN_CAP) { atomicAdd(&(bar)[XB_TMO], 1u); break; } } } } while (0)
struct XcdBarrier { unsigned* bar; unsigned x; volatile LAS unsigned* st; };
__device__ __forceinline__ XcdBarrier xcd_barrier_post(unsigned* bar, volatile LAS unsigned* st) {
  XcdBarrier b; b.bar = bar; b.x = xb_xcc_id(); b.st = st;
  if (threadIdx.x == 0) (void)xb_add(&bar[XB_XCNT(b.x)], 1u);
  return b;
}
__device__ __forceinline__ void xcd_barrier_complete(unsigned* bar, unsigned x, unsigned& nloc, unsigned& nx) {
  const unsigned G = gridDim.x * gridDim.y * gridDim.z;
  unsigned sum, cnt, mine, sp = 0u;
  for (;;) {
    sum = 0u; cnt = 0u; mine = 0u;
#pragma unroll
    for (unsigned j = 0; j < 16; ++j) { const unsigned c = xb_ld(&bar[XB_XCNT(j)]); sum += c; cnt += (c > 0u) ? 1u : 0u; mine = (j == x) ? c : mine; }
    if (sum == G) break;
    __builtin_amdgcn_s_sleep(1);
    if ((++sp & 255u) == 0u) { if (xb_ld(&bar[XB_TMO])) break; if (sp > XB_SPIN_CAP) { atomicAdd(&bar[XB_TMO], 1u); break; } }
  }
  nloc = mine > 0u ? mine : 1u; nx = cnt > 0u ? cnt : 1u;
}
__device__ __forceinline__ void xcd_barrier(const XcdBarrier& b) {
  asm volatile("s_waitcnt vmcnt(0)" ::: "memory");
  __syncthreads();
  if (threadIdx.x == 0) {
    unsigned* bar = b.bar;
    __builtin_amdgcn_s_waitcnt(0);
    unsigned nloc = b.st[0], nx = b.st[1];
    if (nloc == 0u) { xcd_barrier_complete(bar, b.x, nloc, nx); b.st[0] = nloc; b.st[1] = nx; }
    const unsigned old = xb_add(&bar[XB_XSUB(b.x)], 1u);
    const unsigned gen = old / nloc;
    if (old + 1u == (gen + 1u) * nloc) {
      __builtin_amdgcn_fence(__ATOMIC_RELEASE, "agent");
      asm volatile("s_waitcnt vmcnt(0)" ::: "memory");
      const unsigned og = xb_add(&bar[XB_TOP], 1u);
      const unsigned tg = og / nx;
      if (og + 1u == (tg + 1u) * nx) xb_add(&bar[XB_TOPGEN], 1u);
      else XB_SPIN(xb_ld(&bar[XB_TOPGEN]) == tg, bar);
      __builtin_amdgcn_fence(__ATOMIC_ACQUIRE, "agent");
      xb_add(&bar[XB_XGEN(b.x)], 1u);
      asm volatile("s_waitcnt vmcnt(0)" ::: "memory");
    } else {
      XB_SPIN(xb_ld(&bar[XB_XGEN(b.x)]) == gen, bar);
      __builtin_amdgcn_fence(__ATOMIC_ACQUIRE, "agent");
      asm volatile("s_waitcnt vmcnt(0)" ::: "memory");
    }
  }
  __syncthreads();
}

namespace pg8 {
constexpr int BM = 256, BK = 64, HALF = 128, HTB = HALF * BK * 2, NXCD = 8, WGM = 4;
__device__ __forceinline__ int lds_byte(int r, int c) { const int st = (r >> 4) * 2 + (c >> 5), rr = r & 15, cc = c & 31, ob = rr * 64 + cc * 2; return st * 1024 + (ob ^ (((ob >> 9) & 1) << 5)); }
__device__ __forceinline__ void stage_rc(int b, int& R, int& C) { const int st = b / 1024, sb = b % 1024, swz = sb ^ (((sb >> 9) & 1) << 5); R = (st >> 1) * 16 + swz / 64; C = (st & 1) * 32 + (swz % 64) / 2; }
__device__ __forceinline__ int perm32(int rho) { const int n = rho >> 4, i = rho & 15; return 8 * (i >> 2) + 4 * n + (i & 3); }

struct Unit { int pm, pn; };
struct Gemm { const bf16_t* A; const bf16_t* Bt; int nM, nN, K, rstep, roff; };

struct StaticOrder {
  int nM, nN, nwg, G, c;
  __device__ void init(int nM_, int nN_, int G_, int c_) { nM = nM_; nN = nN_; nwg = nM * nN; G = G_; c = c_; }
  __device__ bool next(int i, Unit& u) const {
    const long L = (long)i * G + c; if (L >= nwg) return false;
    int wgid = (int)L; { const int q = nwg / NXCD, r = nwg % NXCD, xcd = wgid % NXCD, off = wgid / NXCD; wgid = (xcd < r ? xcd * (q + 1) : r * (q + 1) + (xcd - r) * q) + off; }
    const int nig = WGM * nN, gid = wgid / nig, fm = gid * WGM, gsz = (nM - fm) < WGM ? (nM - fm) : WGM;
    u.pm = fm + ((wgid % nig) % gsz); u.pn = (wgid % nig) / gsz; return true;
  }
};

template <class Epi>
__device__ __forceinline__ void gemm_phase(LAS unsigned char* lds, const Gemm g, const StaticOrder& S, const Epi& E) {
  int tid = threadIdx.x; asm volatile("" : "+v"(tid));
  const int wid = __builtin_amdgcn_readfirstlane(tid >> 6), lane = tid & 63, wr = wid >> 2, wc = wid & 3, fr = lane & 15, fq = lane >> 4;
  const int K = g.K, nt = K / BK;
  unsigned voffA[2], voffB[2];
#pragma unroll
  for (int i = 0; i < 2; ++i) { int R, C; stage_rc(tid * 16 + i * 8192, R, C); const int Rb = Epi::PERM ? ((R & ~31) + perm32(R & 31)) : R;
    voffA[i] = (unsigned)(R * K + C) * 2u; voffB[i] = (unsigned)(Rb * K + C) * 2u; }
  const size_t kstep = (size_t)(BK * 2);
  const size_t hstep = (size_t)HALF * K * 2;
  const size_t tstepB = 2 * hstep;
  const long rowb = (long)K * 2;
  const unsigned ldsw = (unsigned)wid * 1024u;
  const int aoff = lds_byte(wr * 64 + fr, fq * 8), boff = lds_byte(wc * 32 + fr, fq * 8);
#define PG8_SA(b, h) (((b) * 2 + (h)) * HTB)
#define PG8_SB(b, h) ((4 + (b) * 2 + (h)) * HTB)
#define PG8_STAGE(bufoff, gbase, voff) do { _Pragma("unroll") for (int _i = 0; _i < 2; ++_i) \
    __builtin_amdgcn_global_load_lds((const unsigned*)((const char*)(gbase) + (voff)[_i]), (LAS unsigned*)(lds + (bufoff) + ldsw + _i * 8192), 16, 0, 0); } while (0)
#define PG8_LDA(dst, b, h) do { _Pragma("unroll") for (int m = 0; m < 4; ++m) _Pragma("unroll") for (int k = 0; k < 2; ++k) dst[m][k] = *(const LAS bf16x8*)(lds + PG8_SA(b, h) + aoff + m * 2048 + k * 1024); } while (0)
#define PG8_LDB(dst, b, h) do { _Pragma("unroll") for (int n = 0; n < 2; ++n) _Pragma("unroll") for (int k = 0; k < 2; ++k) dst[n][k] = *(const LAS bf16x8*)(lds + PG8_SB(b, h) + boff + n * 2048 + k * 1024); } while (0)
#define PG8_MMA(ai, bj, At, Bt) do { __builtin_amdgcn_s_setprio(1); _Pragma("unroll") for (int m = 0; m < 4; ++m) _Pragma("unroll") for (int n = 0; n < 2; ++n) _Pragma("unroll") for (int k = 0; k < 2; ++k) \
    acc[ai][bj][m][n] = __builtin_amdgcn_mfma_f32_16x16x32_bf16(Bt[n][k], At[m][k], acc[ai][bj][m][n], 0, 0, 0); __builtin_amdgcn_s_setprio(0); } while (0)
#define PG8_WAIT_V(n) asm volatile("s_waitcnt vmcnt(" #n ")" ::: "memory")
#define PG8_WAIT_L(n) asm volatile("s_waitcnt lgkmcnt(" #n ")" ::: "memory")
#define PG8_BAR __builtin_amdgcn_s_barrier()
#define PG8_SCHED __builtin_amdgcn_sched_barrier(0)
  Unit cur, nxt; int ui = 0;
  if (!S.next(0, cur)) return;
  f32x4 acc[2][2][4][2];
#pragma unroll
  for (int a = 0; a < 2; ++a)
#pragma unroll
    for (int b = 0; b < 2; ++b)
#pragma unroll
      for (int m = 0; m < 4; ++m)
#pragma unroll
        for (int n = 0; n < 2; ++n) acc[a][b][m][n] = (f32x4){0.f, 0.f, 0.f, 0.f};
  bf16x8 At[4][2], B0[2][2], B1[2][2];
  const char* cA = (const char*)g.A + ((long)cur.pm * g.rstep + g.roff) * rowb; const char* cB = (const char*)g.Bt + (size_t)cur.pn * tstepB;
  PG8_STAGE(PG8_SB(0, 0), cB, voffB); PG8_STAGE(PG8_SB(0, 1), cB + hstep, voffB); PG8_STAGE(PG8_SA(0, 0), cA, voffA); PG8_STAGE(PG8_SA(0, 1), cA + hstep, voffA);
  if (wr == 1) PG8_BAR;
  PG8_WAIT_V(2); PG8_BAR;
  PG8_STAGE(PG8_SB(1, 0), cB + kstep, voffB); PG8_STAGE(PG8_SA(1, 0), cA + kstep, voffA); PG8_STAGE(PG8_SB(1, 1), cB + hstep + kstep, voffB);
  PG8_WAIT_V(6); PG8_BAR;
  if (wr == 1) { int lp = lane; asm volatile("" : "+v"(lp)); E.prefetch(cur, lp, wc); }
  for (;;) {
    const bool has_next = S.next(ui + 1, nxt);
    const char* nA = has_next ? (const char*)g.A + ((long)nxt.pm * g.rstep + g.roff) * rowb : cA; const char* nB = has_next ? (const char*)g.Bt + (size_t)nxt.pn * tstepB : cB;
    for (int t = 0; t < nt; t += 2) {
      const bool last = (t == nt - 2);
      const char* a1 = cA + (size_t)(t + 1) * kstep;
      const char* a2 = last ? nA : cA + (size_t)(t + 2) * kstep; const char* b2 = last ? nB : cB + (size_t)(t + 2) * kstep;
      const char* a3 = a2 + kstep; const char* b3 = b2 + kstep;
      PG8_LDB(B0, 0, 0); PG8_LDB(B1, 0, 1); PG8_SCHED; PG8_LDA(At, 0, 0); PG8_STAGE(PG8_SA(1, 1), a1 + hstep, voffA);
      PG8_WAIT_V(8); PG8_WAIT_L(0); PG8_BAR; PG8_MMA(0, 0, At, B0); PG8_MMA(0, 1, At, B1); PG8_BAR; PG8_SCHED;
      PG8_LDA(At, 0, 1); PG8_STAGE(PG8_SB(0, 0), b2, voffB); PG8_STAGE(PG8_SB(0, 1), b2 + hstep, voffB); PG8_STAGE(PG8_SA(0, 0), a2, voffA);
      PG8_WAIT_V(8); PG8_WAIT_L(0); PG8_BAR; PG8_MMA(1, 0, At, B0); PG8_MMA(1, 1, At, B1); PG8_BAR; PG8_SCHED;
      PG8_LDB(B0, 1, 0); PG8_LDB(B1, 1, 1); PG8_SCHED; PG8_LDA(At, 1, 0); PG8_STAGE(PG8_SA(0, 1), a2 + hstep, voffA);
      PG8_WAIT_V(8); PG8_WAIT_L(0); PG8_BAR; PG8_MMA(0, 0, At, B0); PG8_MMA(0, 1, At, B1); PG8_BAR; PG8_SCHED;
      PG8_LDA(At, 1, 1); PG8_STAGE(PG8_SB(1, 0), b3, voffB); PG8_STAGE(PG8_SB(1, 1), b3 + hstep, voffB); PG8_STAGE(PG8_SA(1, 0), a3, voffA);
      PG8_WAIT_V(8); PG8_WAIT_L(0); PG8_BAR; PG8_MMA(1, 0, At, B0); PG8_MMA(1, 1, At, B1); PG8_BAR; PG8_SCHED;
    }
    if (wr == 0) PG8_BAR;
    E(acc, cur, wr, wc, fr, fq);
    if (!has_next) break;
#pragma unroll
    for (int a = 0; a < 2; ++a)
#pragma unroll
      for (int b = 0; b < 2; ++b)
#pragma unroll
        for (int m = 0; m < 4; ++m)
#pragma unroll
          for (int n = 0; n < 2; ++n) acc[a][b][m][n] = (f32x4){0.f, 0.f, 0.f, 0.f};
    cur = nxt; cA = nA; cB = nB; ++ui;
    if (wr == 1) { PG8_BAR;
      int lp = lane; asm volatile("" : "+v"(lp)); E.prefetch(cur, lp, wc); }
  }
  PG8_WAIT_V(0);
  PG8_BAR;
#undef PG8_SA
#undef PG8_SB
#undef PG8_STAGE
#undef PG8_LDA
#undef PG8_LDB
#undef PG8_MMA
#undef PG8_WAIT_V
#undef PG8_WAIT_L
#undef PG8_BAR
#undef PG8_SCHED
}

struct EpiRes {
  static constexpr bool PERM = true;
  bf16_t* hi; float* ss; const float* ssg; LAS float* rtab;
  __device__ __forceinline__ void prefetch(const Unit& u, int lane, int w4) const { if (ssg) __builtin_amdgcn_global_load_lds((const unsigned*)(ssg + u.pm * BM + 64 * w4 + lane), (LAS unsigned*)(rtab + 64 * w4), 4, 0, 0); }
  __device__ __forceinline__ void operator()(f32x4 (&acc)[2][2][4][2], const Unit& u, int wr, int wc, int fr_, int fq_) const {
    int fr = fr_, fq = fq_; asm volatile("" : "+v"(fr), "+v"(fq));
    const int col0 = u.pn * BM + wc * 32 + 8 * fq;
    float part[2][4];
    u32x4 ph[2][4][2];
#pragma unroll
    for (int ai = 0; ai < 2; ++ai)
#pragma unroll
      for (int m = 0; m < 4; ++m) { const unsigned off = (unsigned)(u.pm * BM + ai * HALF + wr * 64 + m * 16 + fr) * DM + col0;
#pragma unroll
        for (int bj = 0; bj < 2; ++bj) ph[ai][m][bj] = *(const u32x4*)(hi + off + bj * HALF); }
    asm volatile("" ::: "memory");
#pragma unroll
    for (int ai = 0; ai < 2; ++ai)
#pragma unroll
      for (int m = 0; m < 4; ++m) { const unsigned off = (unsigned)(u.pm * BM + ai * HALF + wr * 64 + m * 16 + fr) * DM + col0;
        const float rs = ssg ? rsqrtf(ss_f(rtab[ai * HALF + wr * 64 + m * 16 + fr]) * (1.f / SSD_DI) + EPS) : 1.f; float p = 0.f;
#pragma unroll
        for (int bj = 0; bj < 2; ++bj) { u32x4 wh;
#pragma unroll
          for (int n = 0; n < 2; ++n) {
            const unsigned h0 = ph[ai][m][bj][2 * n], h1 = ph[ai][m][bj][2 * n + 1]; const f32x4 a = acc[ai][bj][m][n];
            const float v0 = bflo(h0) + a[0] * rs, v1 = bfhi(h0) + a[1] * rs, v2 = bflo(h1) + a[2] * rs, v3 = bfhi(h1) + a[3] * rs;
            wh[2 * n] = cvtpk(v0, v1); wh[2 * n + 1] = cvtpk(v2, v3); p += (v0 * v0 + v1 * v1) + (v2 * v2 + v3 * v3); }
          *(u32x4*)(hi + off + bj * HALF) = wh; }
        part[ai][m] = p; }
    asm volatile("" ::: "memory");
#pragma unroll
    for (int ai = 0; ai < 2; ++ai)
#pragma unroll
      for (int m = 0; m < 4; ++m) { float p = part[ai][m]; p += __shfl_xor(p, 16); p += __shfl_xor(p, 32);
        if (fq == 0) atomicAdd((int*)ss + u.pm * BM + ai * HALF + wr * 64 + m * 16 + fr, ss_q(p)); }
  }
};

struct EpiQkv {
  static constexpr bool PERM = true;
  bf16_t* Q; bf16_t* Kb; bf16_t* Vt; const float* ssin; LAS float* rtab;
  __device__ __forceinline__ void prefetch(const Unit& u, int lane, int w4) const { __builtin_amdgcn_global_load_lds((const unsigned*)(ssin + u.pm * BM + 64 * w4 + lane), (LAS unsigned*)(rtab + 64 * w4), 4, 0, 0); }
  __device__ __forceinline__ void operator()(f32x4 (&acc)[2][2][4][2], const Unit& u, int wr, int wc, int fr_, int fq_) const {
    int fr = fr_, fq = fq_; asm volatile("" : "+v"(fr), "+v"(fq));
#pragma unroll
    for (int ai = 0; ai < 2; ++ai)
#pragma unroll
      for (int m = 0; m < 4; ++m) { const float rs = rsqrtf(ss_f(rtab[ai * HALF + wr * 64 + m * 16 + fr]) * (1.f / DM) + EPS);
#pragma unroll
        for (int bj = 0; bj < 2; ++bj) { acc[ai][bj][m][0] *= rs; acc[ai][bj][m][1] *= rs; } }
    const int sec = u.pn >> 2, colt = (u.pn & 3) * BM + wc * 32 + 8 * fq;
    if (sec < 2) {
      bf16_t* base = sec == 0 ? Q : Kb; const float sc = sec == 0 ? 0.125f : 1.f;
#pragma unroll
      for (int ai = 0; ai < 2; ++ai)
#pragma unroll
        for (int m = 0; m < 4; ++m) { bf16_t* rowp = base + (size_t)(u.pm * BM + ai * HALF + wr * 64 + m * 16 + fr) * DM + colt;
#pragma unroll
          for (int bj = 0; bj < 2; ++bj) { const f32x4 v0 = acc[ai][bj][m][0] * sc, v1 = acc[ai][bj][m][1] * sc; u32x4 w; w.x = cvtpk(v0[0], v0[1]); w.y = cvtpk(v0[2], v0[3]); w.z = cvtpk(v1[0], v1[1]); w.w = cvtpk(v1[2], v1[3]);
            *(u32x4*)(rowp + bj * HALF) = w; } }
    } else {
#pragma unroll
      for (int ai = 0; ai < 2; ++ai)
#pragma unroll
        for (int m = 0; m < 4; ++m) { const int r = u.pm * BM + ai * HALF + wr * 64 + m * 16 + fr; const int b = r >> 12, s = r & 4095;
#pragma unroll
          for (int bj = 0; bj < 2; ++bj)
#pragma unroll
            for (int n = 0; n < 2; ++n)
#pragma unroll
              for (int j = 0; j < 4; ++j) { const int c = colt + bj * HALF + 4 * n + j;
                Vt[((size_t)(b * 1024 + c)) * SEQ + s] = f2bf(acc[ai][bj][m][n][j]); } }
    }
  }
};

template <int HALO> struct ConvCarry {
  LAS float* carry;
  __device__ __forceinline__ void publish(const f32x4 (&acc)[2][2][4][2], int wr, int wc, int fr, int fq) const {
    if (fr >= 16 - HALO) {
#pragma unroll
      for (int ai = 0; ai < 2; ++ai)
#pragma unroll
        for (int bj = 0; bj < 2; ++bj)
#pragma unroll
          for (int n = 0; n < 2; ++n) *(LAS f32x4*)(carry + ((2 * ai + wr) * HALO + (fr - (16 - HALO))) * 256 + 128 * bj + 32 * wc + 8 * fq + 4 * n) = acc[ai][bj][3][n];
    }
    asm volatile("s_waitcnt lgkmcnt(0)" ::: "memory"); __builtin_amdgcn_s_barrier(); asm volatile("" ::: "memory");
  }
  template <int D> __device__ __forceinline__ f32x4 prev(const f32x4 (&acc)[2][2][4][2], int ai, int bj, int m, int n, int wr, int wc, int fr, int fq) const {
    f32x4 b;
    if (m == 0) { int B = 2 * ai + wr - 1; const bool none = B < 0; B = none ? 0 : B; int ri = HALO + fr - D; ri = ri > HALO - 1 ? HALO - 1 : ri;
      b = *(const LAS f32x4*)(carry + (B * HALO + ri) * 256 + 128 * bj + 32 * wc + 8 * fq + 4 * n);
      if (none) b = (f32x4){0.f, 0.f, 0.f, 0.f}; }
    else b = rot16x4<D>(acc[ai][bj][m - 1][n]);
    f32x4 r;
#pragma unroll
    for (int j = 0; j < 4; ++j) r[j] = __int_as_float(__builtin_amdgcn_update_dpp(__float_as_int(b[j]), __float_as_int(acc[ai][bj][m][n][j]), 0x110 + D, 0xf, 0xf, false));
    return r;
  }
};

struct EpiFfnIn {
  static constexpr bool PERM = true;
  bf16_t* O; const float* cw; const float* cb; ConvCarry<2> cc; const float* ssin; LAS float* rtab; LAS float* wtab; float* PB; float* UB;
  __device__ __forceinline__ void prefetch(const Unit& u, int lane, int w4) const {
    __builtin_amdgcn_global_load_lds((const unsigned*)(ssin + u.pm * 256 + 64 * w4 + lane), (LAS unsigned*)(rtab + 64 * w4), 4, 0, 0);
#pragma unroll
    for (int q = 0; q < 4; ++q) { const int ck = w4 + 4 * q, e = 64 * ck + lane, v = e >> 7, c = 128 * u.pn + (e & 127);
      const float* src = (v & 3) == 3 ? cb + (v >> 2) * FF + c : cw + ((v & 3) * 2 + (v >> 2)) * FF + c; __builtin_amdgcn_global_load_lds((const unsigned*)(src), (LAS unsigned*)(wtab + 64 * ck), 4, 0, 0); } }
  __device__ __forceinline__ void operator()(f32x4 (&acc)[2][2][4][2], const Unit& u, int wr, int wc, int fr_, int fq_) const {
    int fr = fr_, fq = fq_; asm volatile("" : "+v"(fr), "+v"(fq));
#pragma unroll
    for (int ai = 0; ai < 2; ++ai)
#pragma unroll
      for (int m = 0; m < 4; ++m) { const float rs = rsqrtf(ss_f(rtab[128 * ai + 64 * wr + 16 * m + fr]) * (1.f / DM) + EPS);
#pragma unroll
        for (int bj = 0; bj < 2; ++bj) { acc[ai][bj][m][0] *= rs; acc[ai][bj][m][1] *= rs; } }
    cc.publish(acc, wr, wc, fr, fq);
    const bool seq_start = ((u.pm * 256) & (SEQ - 1)) == 0;
    const int ch0 = 128 * u.pn + 32 * wc + 8 * fq;
    if (wr == 1 && fr >= 14) {
#pragma unroll
      for (int n = 0; n < 2; ++n) { float* ub = UB + ((size_t)u.pm * 2 + (fr - 14)) * (2 * FF) + ch0 + 4 * n; *(f32x4*)ub = acc[1][0][3][n]; *(f32x4*)(ub + FF) = acc[1][1][3][n]; } }
#pragma unroll
    for (int n = 0; n < 2; ++n) {
      const int ch = ch0 + 4 * n; const LAS float* wp = wtab + 32 * wc + 8 * fq + 4 * n;
      const f32x4 g0 = *(const LAS f32x4*)(wp), g1 = *(const LAS f32x4*)(wp + 128), g2 = *(const LAS f32x4*)(wp + 256), gb = *(const LAS f32x4*)(wp + 384);
      const f32x4 u0 = *(const LAS f32x4*)(wp + 512), u1 = *(const LAS f32x4*)(wp + 640), u2 = *(const LAS f32x4*)(wp + 768), ub = *(const LAS f32x4*)(wp + 896);
#pragma unroll
      for (int ai = 0; ai < 2; ++ai)
#pragma unroll
        for (int m = 0; m < 4; ++m) {
          const int i = 128 * ai + 64 * wr + 16 * m + fr; const int tok = u.pm * 256 + i;
          const f32x4 G1 = cc.prev<1>(acc, ai, 0, m, n, wr, wc, fr, fq), G2 = cc.prev<2>(acc, ai, 0, m, n, wr, wc, fr, fq);
          const f32x4 U1 = cc.prev<1>(acc, ai, 1, m, n, wr, wc, fr, fq), U2 = cc.prev<2>(acc, ai, 1, m, n, wr, wc, fr, fq);
          const f32x4 cg_ = gb + g2 * acc[ai][0][m][n] + g1 * G1 + g0 * G2;
          const f32x4 cu_ = ub + u2 * acc[ai][1][m][n] + u1 * U1 + u0 * U2;
          if (ai == 0 && m == 0 && !seq_start && wr == 0 && fr < 2) {
            float* pb = PB + ((size_t)u.pm * 2 + fr) * (2 * FF) + ch; *(f32x4*)pb = cg_; *(f32x4*)(pb + FF) = cu_;
          } else {
            u32x2 w; w.x = cvtpk(silu_f(cg_[0]) * cu_[0], silu_f(cg_[1]) * cu_[1]); w.y = cvtpk(silu_f(cg_[2]) * cu_[2], silu_f(cg_[3]) * cu_[3]);
            *(u32x2*)(O + (size_t)tok * FF + ch) = w;
          }
        }
      asm volatile("" ::: "memory");
    }
  }
};

struct EpiSsdIn {
  static constexpr bool PERM = true;
  bf16_t* Z; bf16_t* XBC; float* DT; const float* cw; const float* cb; const float* dtb; ConvCarry<3> cc; const float* ssin; LAS float* rtab; LAS float* wtab;
  __device__ __forceinline__ void prefetch(const Unit& u, int lane, int w4) const {
    { int tok = u.pm * 253 - 3 + 64 * w4 + lane; tok = tok < 0 ? 0 : (tok > T - 1 ? T - 1 : tok); __builtin_amdgcn_global_load_lds((const unsigned*)(ssin + tok), (LAS unsigned*)(rtab + 64 * w4), 4, 0, 0); }
    if (u.pn >= 8 && u.pn < 24) {
#pragma unroll
      for (int q = 0; q < 5; ++q) { const int ck = w4 + 4 * q, e = 64 * ck + lane, v = e >> 8, c = (u.pn - 8) * BM + (e & 255); const float* src = v == 4 ? cb + c : cw + v * SSD_CONVD + c; __builtin_amdgcn_global_load_lds((const unsigned*)(src), (LAS unsigned*)(wtab + 64 * ck), 4, 0, 0); } } }
  __device__ __forceinline__ void operator()(f32x4 (&acc)[2][2][4][2], const Unit& u, int wr, int wc, int fr_, int fq_) const {
    int fr = fr_, fq = fq_; asm volatile("" : "+v"(fr), "+v"(fq));
#pragma unroll
    for (int ai = 0; ai < 2; ++ai)
#pragma unroll
      for (int m = 0; m < 4; ++m) { const float rs = rsqrtf(ss_f(rtab[128 * ai + 64 * wr + 16 * m + fr]) * (1.f / DM) + EPS);
#pragma unroll
        for (int bj = 0; bj < 2; ++bj) { acc[ai][bj][m][0] *= rs; acc[ai][bj][m][1] *= rs; } }
    if (u.pn < 8) {
      const int col0 = u.pn * BM + wc * 32 + 8 * fq;
#pragma unroll
      for (int ai = 0; ai < 2; ++ai)
#pragma unroll
        for (int m = 0; m < 4; ++m) { const int i = 128 * ai + 64 * wr + 16 * m + fr; const int tok = u.pm * 253 - 3 + i;
          if (i >= 3 && tok < T) {
#pragma unroll
            for (int bj = 0; bj < 2; ++bj) { const f32x4 v0 = acc[ai][bj][m][0], v1 = acc[ai][bj][m][1]; u32x4 w; w.x = cvtpk(v0[0], v0[1]); w.y = cvtpk(v0[2], v0[3]); w.z = cvtpk(v1[0], v1[1]); w.w = cvtpk(v1[2], v1[3]);
              *(u32x4*)(Z + (size_t)tok * SSD_DI + col0 + bj * HALF) = w; } } }
    } else if (u.pn < 24) {
      cc.publish(acc, wr, wc, fr, fq);
      const int tlo = u.pm * 253 - 3; const bool has_bnd = tlo < 0 || (tlo & (SEQ - 1)) + 255 >= SEQ || (tlo & (SEQ - 1)) < 3;
      const int ch0 = (u.pn - 8) * BM + wc * 32 + 8 * fq;
#pragma unroll
      for (int bj = 0; bj < 2; ++bj)
#pragma unroll
        for (int n = 0; n < 2; ++n) {
          const int ch = ch0 + 128 * bj + 4 * n; const LAS float* wp = wtab + 128 * bj + 32 * wc + 8 * fq + 4 * n;
          const f32x4 w0 = *(const LAS f32x4*)(wp), w1 = *(const LAS f32x4*)(wp + 256), w2 = *(const LAS f32x4*)(wp + 512), w3 = *(const LAS f32x4*)(wp + 768), bb = *(const LAS f32x4*)(wp + 1024);
#pragma unroll
          for (int ai = 0; ai < 2; ++ai)
#pragma unroll
            for (int m = 0; m < 4; ++m) {
              const int i = 128 * ai + 64 * wr + 16 * m + fr; const int tok = u.pm * 253 - 3 + i; const int tb = tok & (SEQ - 1);
              f32x4 V1 = cc.prev<1>(acc, ai, bj, m, n, wr, wc, fr, fq), V2 = cc.prev<2>(acc, ai, bj, m, n, wr, wc, fr, fq), V3 = cc.prev<3>(acc, ai, bj, m, n, wr, wc, fr, fq);
              if (has_bnd) { const f32x4 zero = {0.f, 0.f, 0.f, 0.f}; if (tb < 1) V1 = zero; if (tb < 2) V2 = zero; if (tb < 3) V3 = zero; }
              const f32x4 c_ = bb + w3 * acc[ai][bj][m][n] + w2 * V1 + w1 * V2 + w0 * V3;
              u32x2 w; w.x = cvtpk(silu_f(c_[0]), silu_f(c_[1])); w.y = cvtpk(silu_f(c_[2]), silu_f(c_[3]));
              if (i >= 3 && tok < T) *(u32x2*)(XBC + (size_t)tok * SSD_CONVD + ch) = w;
            }
          asm volatile("" ::: "memory");
        }
    } else {
      if (wc == 0) {
#pragma unroll
        for (int n = 0; n < 2; ++n) { const int c = 8 * fq + 4 * n; const f32x4 bv = *(const f32x4*)(dtb + c);
#pragma unroll
          for (int ai = 0; ai < 2; ++ai)
#pragma unroll
            for (int m = 0; m < 4; ++m) { const int i = 128 * ai + 64 * wr + 16 * m + fr; const int tok = u.pm * 253 - 3 + i;
              f32x4 v = acc[ai][0][m][n] + bv;
#pragma unroll
              for (int j = 0; j < 4; ++j) v[j] = fmaxf(v[j], 0.f) + log1pf(__expf(-fabsf(v[j])));
              if (i >= 3 && tok < T) *(f32x4*)(DT + (size_t)tok * SSD_H + c) = v; } }
      }
    }
  }
};
}

__device__ __forceinline__ void transpose_item(const float* W, const float* gk, int K, int N, bf16_t* WT, int k0, int n0, int drow0, LAS float* scr, int lane) {
  f32x4 v[8];
#pragma unroll
  for (int i = 0; i < 8; ++i) v[i] = __builtin_nontemporal_load((const f32x4*)(W + (size_t)(k0 + 8 * i + (lane >> 3)) * N + n0 + 4 * (lane & 7)));
#pragma unroll
  for (int i = 0; i < 8; ++i) { const int kk = 8 * i + (lane >> 3); const float g = gk ? gk[k0 + kk] : 1.f; LAS float* d = scr + kk * 33 + 4 * (lane & 7);
    d[0] = v[i].x * g; d[1] = v[i].y * g; d[2] = v[i].z * g; d[3] = v[i].w * g; }
  asm volatile("s_waitcnt lgkmcnt(0)" ::: "memory");
  const int c = lane & 7;
#pragma unroll
  for (int j = 0; j < 4; ++j) { const int n = (lane >> 3) + 8 * j; const LAS float* s = scr + (8 * c) * 33 + n;
    u32x4 o; o.x = cvtpk(s[0 * 33], s[1 * 33]); o.y = cvtpk(s[2 * 33], s[3 * 33]); o.z = cvtpk(s[4 * 33], s[5 * 33]); o.w = cvtpk(s[6 * 33], s[7 * 33]);
    *(u32x4*)(WT + (size_t)(drow0 + n) * K + k0 + 8 * c) = o; }
  asm volatile("s_waitcnt lgkmcnt(0)" ::: "memory");
}
__device__ __forceinline__ void convert_weight(const float* W, const float* gk, int K, int N, bf16_t* WT, int kind, LAS float* scr, int gw, int ngw, int lane) {
  const int nblk = N / 32, items = (K / 64) * nblk;
  for (int it = gw; it < items; it += ngw) {
    const int kb = it / nblk, nb = it % nblk, n0 = nb * 32;
    int drow0 = n0;
    if (kind == 1) { drow0 = n0 < FF ? (256 * (n0 >> 7) + (n0 & 127)) : (256 * ((n0 - FF) >> 7) + 128 + ((n0 - FF) & 127)); }
    transpose_item(W, gk, K, N, WT, kb * 64, n0, drow0, scr, lane);
  }
}
__device__ __forceinline__ int pi32(int r) { return 16 * (r >> 4) + 8 * ((r >> 2) & 1) + 4 * ((r >> 3) & 1) + (r & 3); }
__device__ __forceinline__ void ssd_scan_phase(const Params& P, LAS unsigned char* lds, int layer_j, bf16_t* Gout, float* SSG) {
  constexpr int RS = 136;
  LAS bf16_t* Bs = (LAS bf16_t*)lds;
  LAS bf16_t* BwT = Bs + 128 * RS;
  LAS bf16_t* Cs = BwT + 128 * RS;
  LAS bf16_t* XT = Cs + 128 * RS;
  LAS bf16_t* St = XT + 64 * RS;
  LAS float* tab0 = (LAS float*)(St + 64 * RS);
  const bf16_t* XBC = (const bf16_t*)(P.ws + WS_XBC); const bf16_t* Z = (const bf16_t*)(P.ws + WS_Z); const float* DT = (const float*)(P.ws + WS_DT);
  int tid0 = threadIdx.x; asm volatile("" : "+v"(tid0));
  const int wid = __builtin_amdgcn_readfirstlane(tid0 >> 6);
  const int tb = wid >> 1, pb = wid & 1;
#define SCAN_LANE() int tid = tid0; asm volatile("" : "+v"(tid)); const int lane = tid & 63, l32 = lane & 31, hh = lane >> 5; (void)l32; (void)hh
  for (int item = blockIdx.x; item < 256; item += gridDim.x) {
    const int b = item >> 5, hd = item & 31, grp = hd >> 2;
    const float Aneg = -__expf(P.ssd_a_log[layer_j * SSD_H + hd]), Dh = P.ssd_d[layer_j * SSD_H + hd];
    f32x16 st;
#pragma unroll
    for (int i = 0; i < 16; ++i) st[i] = 0.f;
    for (int e = tid0; e < 64 * RS / 2; e += NTHREADS) ((LAS unsigned*)St)[e] = 0u;
    const unsigned vo_bc0 = (unsigned)(tid0 >> 4) * 8192u + (unsigned)(2048 + grp * 128 + (tid0 & 15) * 8) * 2u;
    const unsigned vo_colb = (unsigned)(hd * 64 + 32 * pb + 8 * (tid0 & 3)) * 2u, vo_row = (unsigned)(32 * tb + ((tid0 & 63) >> 2));
    const unsigned vo_xq0 = vo_row * 8192u + vo_colb, vo_zq0 = vo_row * 4096u + vo_colb;
    const char* xbc_b = (const char*)XBC + (size_t)b * SEQ * 8192; const char* z_b = (const char*)Z + (size_t)b * SEQ * 4096; char* g_b = (char*)Gout + (size_t)b * SEQ * 4096;
    u32x4 vb[4], vc[4], xq[2], zq[2], xqn[2], zqn[2]; float d0 = 0.f, d1 = 0.f; float ssq_prev[2] = {0.f, 0.f};
#define SCAN_LOADS(T0, XQ, ZQ) do { const char* cb_ = xbc_b + (size_t)(T0) * 8192; const char* zb_ = z_b + (size_t)(T0) * 4096; unsigned vo_bc = vo_bc0, vo_xq = vo_xq0, vo_zq = vo_zq0; asm volatile("" : "+v"(vo_bc), "+v"(vo_xq), "+v"(vo_zq)); \
      d0 = DT[(size_t)(b * SEQ + (T0) + 2 * (tid0 & 63)) * SSD_H + hd]; d1 = DT[(size_t)(b * SEQ + (T0) + 2 * (tid0 & 63) + 1) * SSD_H + hd];     \
      _Pragma("unroll") for (int k = 0; k < 4; ++k) { vb[k] = *(const u32x4*)(cb_ + (size_t)(32 * k) * 8192 + vo_bc); vc[k] = *(const u32x4*)(cb_ + (size_t)(32 * k) * 8192 + 2048 + vo_bc); } \
      _Pragma("unroll") for (int k = 0; k < 2; ++k) { XQ[k] = *(const u32x4*)(cb_ + (size_t)(16 * k) * 8192 + vo_xq); ZQ[k] = *(const u32x4*)(zb_ + (size_t)(16 * k) * 4096 + vo_zq); } \
      } while (0)
#define SCAN_TABLES(TB_) do { LAS float* ta_ = (TB_); const int ln_ = tid0 & 63, s0 = 2 * ln_; const float a0 = Aneg * d0, a1 = Aneg * d1; float s = a0 + a1; \
      _Pragma("unroll") for (int o = 1; o < 64; o <<= 1) { const float v = __shfl_up(s, o); if (ln_ >= o) s += v; } \
      const float tot = __shfl(s, 63), bend = __shfl(s, (ln_ & ~15) | 15), c0 = s - a1; \
      ta_[s0] = c0; ta_[s0 + 1] = s; ta_[128 + s0] = d0; ta_[128 + s0 + 1] = d1; \
      ta_[256 + s0] = __expf(tot - c0); ta_[256 + s0 + 1] = __expf(tot - s); ta_[384 + s0] = __expf(c0); ta_[384 + s0 + 1] = __expf(s); \
      ta_[512 + s0] = __expf(bend - c0); ta_[512 + s0 + 1] = __expf(bend - s); } while (0)
    SCAN_LOADS(0, xq, zq);
    __builtin_amdgcn_s_waitcnt(0x0F70);
    if (wid == 0) SCAN_TABLES(tab0);
    for (int c = 0; c < 32; ++c) {
      const int t0 = b * SEQ + 128 * c;
      LAS float* acum = tab0 + (c & 1) * 640; LAS float* dts = acum + 128; LAS float* wdec = acum + 256; LAS float* eacum = acum + 384; LAS float* cfac = acum + 512;
      {
      { SCAN_LANE();
#pragma unroll
      for (int k = 0; k < 4; ++k) { const int s = (tid >> 4) + 32 * k, n8 = tid & 15; *(LAS u32x4*)(Bs + s * RS + n8 * 8) = vb[k]; *(LAS u32x4*)(Cs + s * RS + n8 * 8) = vc[k]; }
      }
      __syncthreads();
      { SCAN_LANE();
#pragma unroll
      for (int k = 0; k < 2; ++k) { const int s = 32 * tb + (lane >> 2) + 16 * k, p0 = 32 * pb + 8 * (lane & 3); const float dv = dts[s];
#pragma unroll
        for (int e = 0; e < 4; ++e) { XT[(p0 + 2 * e) * RS + s] = f2bf(bflo(xq[k][e]) * dv); XT[(p0 + 2 * e + 1) * RS + s] = f2bf(bfhi(xq[k][e]) * dv); } }
#pragma unroll
      for (int k = 0; k < 4; ++k) { const int id = tid + NTHREADS * k, n = id & 127, s8 = id >> 7; float bv[8];
#pragma unroll
        for (int j = 0; j < 8; ++j) bv[j] = bf2f(Bs[(8 * s8 + j) * RS + n]) * wdec[8 * s8 + j];
        u32x4 w; w.x = cvtpk(bv[0], bv[1]); w.y = cvtpk(bv[2], bv[3]); w.z = cvtpk(bv[4], bv[5]); w.w = cvtpk(bv[6], bv[7]);
        *(LAS u32x4*)(BwT + n * RS + 8 * s8) = w; } }
      __syncthreads();
      }
      if (c > 0) { SCAN_LANE(); if ((lane & 3) == 0) { float* sp = SSG + (t0 - 128) + 32 * tb + (lane >> 2); atomicAdd((int*)sp, ss_q(ssq_prev[0])); atomicAdd((int*)sp + 16, ss_q(ssq_prev[1])); } }
      if (c + 1 < 32) SCAN_LOADS(128 * (c + 1), xqn, zqn);
      f32x16 y;
      { SCAN_LANE();
#pragma unroll
      for (int i = 0; i < 16; ++i) y[i] = 0.f;
      bf16x8 cf[8];
      { const LAS bf16_t* cp = Cs + (32 * tb + l32) * RS + 8 * hh;
#pragma unroll
        for (int kk = 0; kk < 8; ++kk) cf[kk] = *(const LAS bf16x8*)(cp + 16 * kk); }
      { const LAS bf16_t* bp = St + (32 * pb + l32) * RS + 8 * hh;
        const int pt = wid & 1, nt = wid >> 1; const float dl = eacum[127];
#pragma unroll
        for (int i = 0; i < 16; ++i) st[i] *= dl;
        const LAS bf16_t* ap2 = XT + (32 * pt + l32) * RS + 8 * hh; const LAS bf16_t* bp2 = BwT + (32 * nt + l32) * RS + 8 * hh;
#pragma unroll
        for (int kk = 0; kk < 8; ++kk) { y = mfma32(cf[kk], *(const LAS bf16x8*)(bp + 16 * kk), y); st = mfma32(*(const LAS bf16x8*)(ap2 + 16 * kk), *(const LAS bf16x8*)(bp2 + 16 * kk), st); } }
#pragma unroll
      for (int i = 0; i < 16; ++i) y[i] *= eacum[32 * tb + 8 * (i >> 2) + 4 * hh + (i & 3)];
      const float at = acum[32 * tb + l32];
      f32x16 S0, S1;
#define SCAN_CB(SB) do { _Pragma("unroll") for (int i = 0; i < 16; ++i) { S0[i] = 0.f; S1[i] = 0.f; } \
        const LAS bf16_t* ap_ = Bs + (32 * (SB) + pi32(l32)) * RS + 8 * hh; \
        _Pragma("unroll") for (int kk = 0; kk < 8; kk += 2) { S0 = mfma32(*(const LAS bf16x8*)(ap_ + 16 * kk), cf[kk], S0); S1 = mfma32(*(const LAS bf16x8*)(ap_ + 16 * kk + 16), cf[kk + 1], S1); } } while (0)
      SCAN_CB(0);
      for (int sb = 0; sb <= tb; ++sb) {
        float sv[16];
#pragma unroll
        for (int i = 0; i < 16; ++i) sv[i] = S0[i] + S1[i];
        if (sb < tb) SCAN_CB(sb + 1);
        float pv[16];
        if (sb < tb) {
          const float rowf = __expf(at - acum[32 * sb + 31]);
#pragma unroll
          for (int i = 0; i < 16; ++i) pv[i] = sv[i] * (rowf * cfac[32 * sb + 16 * (i >> 3) + 8 * hh + (i & 7)]);
        } else {
#pragma unroll
          for (int i = 0; i < 16; ++i) { const int sl = 16 * (i >> 3) + 8 * hh + (i & 7); const float dec = __expf(at - acum[32 * sb + sl]); pv[i] = (sl <= l32) ? sv[i] * dec : 0.f; }
        }
        u32x4 p0, p1; p0.x = cvtpk(pv[0], pv[1]); p0.y = cvtpk(pv[2], pv[3]); p0.z = cvtpk(pv[4], pv[5]); p0.w = cvtpk(pv[6], pv[7]);
        p1.x = cvtpk(pv[8], pv[9]); p1.y = cvtpk(pv[10], pv[11]); p1.z = cvtpk(pv[12], pv[13]); p1.w = cvtpk(pv[14], pv[15]);
        const LAS bf16_t* xb = XT + (32 * pb + l32) * RS + 32 * sb + 8 * hh;
        y = mfma32(__builtin_bit_cast(bf16x8, p0), *(const LAS bf16x8*)(xb), y);
        y = mfma32(__builtin_bit_cast(bf16x8, p1), *(const LAS bf16x8*)(xb + 16), y);
      }
#undef SCAN_CB
      }
      if (wid == 0 && c + 1 < 32) SCAN_TABLES(tab0 + ((c + 1) & 1) * 640);
      __syncthreads();
      { SCAN_LANE();
      { const int pt = wid & 1, nt = wid >> 1;
#pragma unroll
        for (int i = 0; i < 16; ++i) St[(32 * pt + 8 * (i >> 2) + 4 * hh + (i & 3)) * RS + 32 * nt + l32] = f2bf(st[i]); }
      LAS float* ys = (LAS float*)BwT + wid * (32 * 34);
#pragma unroll
      for (int i = 0; i < 16; ++i) ys[(8 * (i >> 2) + 4 * hh + (i & 3)) * 34 + l32] = y[i];
      asm volatile("s_waitcnt lgkmcnt(0)" ::: "memory");
      char* gb_ = g_b + (size_t)(128 * c) * 4096; unsigned vo_zq = vo_zq0; asm volatile("" : "+v"(vo_zq));
#pragma unroll
      for (int k = 0; k < 2; ++k) { const int row = (lane >> 2) + 16 * k; const LAS f32x2_t* yp = (const LAS f32x2_t*)(ys + row * 34 + 8 * (lane & 3));
        float yv[8];
#pragma unroll
        for (int e = 0; e < 4; ++e) { const f32x2_t t2 = yp[e]; yv[2 * e] = t2.x; yv[2 * e + 1] = t2.y; }
        float gv[8]; float ssq = 0.f;
#pragma unroll
        for (int e = 0; e < 4; ++e) { gv[2 * e] = (yv[2 * e] + Dh * bflo(xq[k][e])) * silu_f(bflo(zq[k][e])); gv[2 * e + 1] = (yv[2 * e + 1] + Dh * bfhi(xq[k][e])) * silu_f(bfhi(zq[k][e]));
          ssq += gv[2 * e] * gv[2 * e] + gv[2 * e + 1] * gv[2 * e + 1]; }
        u32x4 w; w.x = cvtpk(gv[0], gv[1]); w.y = cvtpk(gv[2], gv[3]); w.z = cvtpk(gv[4], gv[5]); w.w = cvtpk(gv[6], gv[7]);
        *(u32x4*)(gb_ + (size_t)(16 * k) * 4096 + vo_zq) = w;
        ssq += __shfl_xor(ssq, 1); ssq += __shfl_xor(ssq, 2);
        ssq_prev[k] = ssq; }
      }
#pragma unroll
      for (int k = 0; k < 2; ++k) { xq[k] = xqn[k]; zq[k] = zqn[k]; }
    }
    { SCAN_LANE(); if ((lane & 3) == 0) { float* sp = SSG + (b * SEQ + 128 * 31) + 32 * tb + (lane >> 2); atomicAdd((int*)sp, ss_q(ssq_prev[0])); atomicAdd((int*)sp + 16, ss_q(ssq_prev[1])); } }
#undef SCAN_LOADS
#undef SCAN_LANE
#undef SCAN_TABLES
    __syncthreads();
  }
}

__device__ __forceinline__ void sb_attn_phase(const Params& P) {
  const bf16_t* Q = (const bf16_t*)(P.ws + WS_Q); const bf16_t* Kb = (const bf16_t*)(P.ws + WS_K); const bf16_t* Vt = (const bf16_t*)(P.ws + WS_VT); bf16_t* O = (bf16_t*)(P.ws + WS_O);
  int tid = threadIdx.x; asm volatile("" : "+v"(tid));
  const int lane = tid & 63, wid = __builtin_amdgcn_readfirstlane(tid >> 6), l32 = lane & 31, hh = lane >> 5;
  const int gw = blockIdx.x * 8 + wid, ngw = gridDim.x * 8;
  for (int item = gw; item < 8 * 16 * 128; item += ngw) {
    const int qt = 127 - (item >> 7), bh = item & 127, b = bh >> 4, h = bh & 15;
    const int q0 = 32 * qt; const size_t rowbase = (size_t)b * SEQ;
    bf16x8 qf[4];
#pragma unroll
    for (int d0 = 0; d0 < 4; ++d0) qf[d0] = *(const bf16x8*)(Q + (rowbase + q0 + l32) * DM + h * 64 + 16 * d0 + 8 * hh);
    f32x16 o0, o1;
#pragma unroll
    for (int i = 0; i < 16; ++i) { o0[i] = 0.f; o1[i] = 0.f; }
    float R = 0.f;
    const bf16_t* vbase = Vt + ((size_t)(bh * 64 + l32)) * SEQ + 8 * hh;
    const bf16_t* kbase = Kb + (rowbase + pi32(l32)) * DM + h * 64 + 8 * hh;
    bf16x8 kn[4];
#pragma unroll
    for (int d0 = 0; d0 < 4; ++d0) kn[d0] = *(const bf16x8*)(kbase + (size_t)q0 * DM + 16 * d0);
    for (int kb = q0; kb >= 0; kb -= 32) {
      f32x16 S;
#pragma unroll
      for (int i = 0; i < 16; ++i) S[i] = 0.f;
      bf16x8 kf[4], vf[4];
#pragma unroll
      for (int d0 = 0; d0 < 4; ++d0) kf[d0] = kn[d0];
      { const bf16_t* vp = vbase + kb;
        vf[0] = *(const bf16x8*)(vp); vf[1] = *(const bf16x8*)(vp + 16); vf[2] = *(const bf16x8*)(vp + 32 * SEQ); vf[3] = *(const bf16x8*)(vp + 32 * SEQ + 16); }
      if (kb >= 32) {
#pragma unroll
        for (int d0 = 0; d0 < 4; ++d0) kn[d0] = *(const bf16x8*)(kbase + (size_t)(kb - 32) * DM + 16 * d0); }
#pragma unroll
      for (int d0 = 0; d0 < 4; ++d0) S = mfma32(kf[d0], qf[d0], S);
      float lb[16], lf[16]; float g0 = 0.f, g1 = 0.f;
#pragma unroll
      for (int i = 0; i < 16; ++i) { const float L = S[i]; const int kl = 16 * (i >> 3) + 8 * hh + (i & 7); const bool ok = (kb < q0) || (kl < l32);
        const float sp = __logf(1.f + __expf(-fabsf(L)));
        lb[i] = fminf(L, 0.f) - sp; const float f = ok ? (lb[i] - L) : 0.f; lf[i] = f; if (i < 8) g0 += f; else g1 += f;
        if (!ok) lb[i] = -1e30f; }
      const float h0 = __shfl_xor(g0, 32), h1 = __shfl_xor(g1, 32);
      const float after0 = hh == 0 ? (h0 + g1 + h1) : (h1 + g1);
      const float after1 = hh == 0 ? h1 : 0.f;
      float pw[16]; float run = after0 + R;
#pragma unroll
      for (int i = 7; i >= 0; --i) { pw[i] = __expf(lb[i] + run); run += lf[i]; }
      run = after1 + R;
#pragma unroll
      for (int i = 15; i >= 8; --i) { pw[i] = __expf(lb[i] + run); run += lf[i]; }
      R += (g0 + g1) + (h0 + h1);
      u32x4 p0, p1; p0.x = cvtpk(pw[0], pw[1]); p0.y = cvtpk(pw[2], pw[3]); p0.z = cvtpk(pw[4], pw[5]); p0.w = cvtpk(pw[6], pw[7]);
      p1.x = cvtpk(pw[8], pw[9]); p1.y = cvtpk(pw[10], pw[11]); p1.z = cvtpk(pw[12], pw[13]); p1.w = cvtpk(pw[14], pw[15]);
      o0 = mfma32(__builtin_bit_cast(bf16x8, p0), vf[0], o0);
      o0 = mfma32(__builtin_bit_cast(bf16x8, p1), vf[1], o0);
      o1 = mfma32(__builtin_bit_cast(bf16x8, p0), vf[2], o1);
      o1 = mfma32(__builtin_bit_cast(bf16x8, p1), vf[3], o1);
      if (__all(R < -104.f)) break;
    }
#pragma unroll
    for (int i = 0; i < 16; ++i) { bf16_t* op = O + (rowbase + q0 + 8 * (i >> 2) + 4 * hh + (i & 3)) * DM + h * 64 + l32; op[0] = f2bf(o0[i]); op[32] = f2bf(o1[i]); }
  }
}

struct WaveId { int lane, wid, gw, ngw; };
__device__ __forceinline__ WaveId wave_id() { int tid = threadIdx.x; asm volatile("" : "+v"(tid)); WaveId w; w.lane = tid & 63; w.wid = __builtin_amdgcn_readfirstlane(tid >> 6); w.gw = blockIdx.x * 8 + w.wid; w.ngw = gridDim.x * 8; return w; }
__device__ __forceinline__ void prologue_phase(const float* x, bf16_t* XB, float* ss0) { const WaveId w = wave_id();
  for (int m = w.gw; m < T; m += w.ngw) { const f32x4* xr = (const f32x4*)(x + (size_t)m * DM) + w.lane; u32x2* hrow = (u32x2*)(XB + (size_t)m * DM); float s = 0.f;
#pragma unroll
    for (int j = 0; j < 4; ++j) { const f32x4 v = __builtin_nontemporal_load(xr + 64 * j); s += (v.x * v.x + v.y * v.y) + (v.z * v.z + v.w * v.w); u32x2 h; h.x = cvtpk(v.x, v.y); h.y = cvtpk(v.z, v.w); hrow[w.lane + 64 * j] = h; }
    s = wave_sum(s); if (w.lane == 0) ((int*)ss0)[m] = ss_q(s); } }
__device__ __forceinline__ void final_norm_phase(const bf16_t* XB, float* out, const float* g, const float* ss) { const WaveId w = wave_id();
  for (int m = w.gw; m < T; m += w.ngw) { const u32x2* hrow = (const u32x2*)(XB + (size_t)m * DM); f32x4* orow = (f32x4*)(out + (size_t)m * DM) + w.lane;
    const f32x4* gr = (const f32x4*)g + w.lane; const float rstd = rsqrtf(ss_f(ss[m]) * (1.f / DM) + EPS);
#pragma unroll
    for (int j = 0; j < 4; ++j) { const u32x2 h = hrow[w.lane + 64 * j]; const f32x4 v = {bflo(h.x), bfhi(h.x), bflo(h.y), bfhi(h.y)}; __builtin_nontemporal_store(v * rstd * gr[64 * j], orow + 64 * j); } } }
__device__ __forceinline__ void zero_phase(float* a, float* b) { int tid = threadIdx.x; asm volatile("" : "+v"(tid));
  for (int i = blockIdx.x * NTHREADS + tid; i < T; i += gridDim.x * NTHREADS) { a[i] = 0.f; if (b) b[i] = 0.f; } }
__device__ __forceinline__ void convert_phase(const float* W, const float* gk, int K, int N, bf16_t* WT, int kind, LAS unsigned char* lds, int& cum) { const WaveId w = wave_id();
  const int rot = cum % w.ngw, first = w.gw >= rot ? w.gw - rot : w.gw + w.ngw - rot;
  convert_weight(W, gk, K, N, WT, kind, (LAS float*)(lds + w.wid * 16384), first, w.ngw, w.lane); cum += (K / 64) * (N / 32); }
__device__ __forceinline__ void convert_mixer(const Params& P, int layer, bf16_t* Wmi, bf16_t* Wmo, LAS unsigned char* lds, int& cum) {
  const int j = layer >> 1;
  if ((layer & 1) == 0) {
    convert_phase(P.ssd_w_in + (size_t)j * DM * SSD_IN, P.mix_norm + layer * DM, DM, SSD_IN, Wmi, 0, lds, cum);
    convert_phase(P.ssd_w_out + (size_t)j * SSD_DI * DM, P.ssd_norm + j * SSD_DI, SSD_DI, DM, Wmo, 0, lds, cum);
  } else {
    convert_phase(P.sb_w_qkv + (size_t)j * DM * 3 * DM, P.mix_norm + layer * DM, DM, 3 * DM, Wmi, 0, lds, cum);
    convert_phase(P.sb_w_out + (size_t)j * DM * DM, nullptr, DM, DM, Wmo, 0, lds, cum);
  }
}

__device__ __forceinline__ void ffn_fixup_tile(int pm, const float* PB, const float* UB, const float* cw, bf16_t* A) {
  if (pm == 0 || (pm & 15) == 0) return;
  int tid = threadIdx.x; asm volatile("" : "+v"(tid));
  for (int it = tid; it < 2 * (FF / 4); it += NTHREADS) {
    const int q = it % (FF / 4), r = it / (FF / 4), c = 4 * q;
    const float* pb = PB + ((size_t)pm * 2 + r) * (2 * FF) + c; const float* ub = UB + ((size_t)(pm - 1) * 2) * (2 * FF) + c;
    f32x4 g = *(const f32x4*)pb, uu = *(const f32x4*)(pb + FF);
    const f32x4 g0 = *(const f32x4*)(cw + c), g1 = *(const f32x4*)(cw + 2 * FF + c), u0 = *(const f32x4*)(cw + FF + c), u1 = *(const f32x4*)(cw + 3 * FF + c);
    const f32x4 pg254 = *(const f32x4*)ub, pu254 = *(const f32x4*)(ub + FF), pg255 = *(const f32x4*)(ub + 2 * FF), pu255 = *(const f32x4*)(ub + 3 * FF);
    if (r == 0) { g += g1 * pg255 + g0 * pg254; uu += u1 * pu255 + u0 * pu254; }
    else        { g += g0 * pg255;              uu += u0 * pu255; }
    u32x2 w; w.x = cvtpk(silu_f(g[0]) * uu[0], silu_f(g[1]) * uu[1]); w.y = cvtpk(silu_f(g[2]) * uu[2], silu_f(g[3]) * uu[3]);
    *(u32x2*)(A + (size_t)(pm * 256 + r) * FF + c) = w;
  }
}

__global__ void __launch_bounds__(NTHREADS, 2) fwd_megakernel(Params P) {
  extern __shared__ __attribute__((aligned(16))) unsigned char lds_raw[];
  LAS unsigned char* lds = (LAS unsigned char*)lds_raw;
  cg::grid_group grid = cg::this_grid();
  const int G = gridDim.x;
  unsigned char* ws = P.ws;
  bf16_t* Wmi = (bf16_t*)(ws + WS_WMI); bf16_t* Wmo = (bf16_t*)(ws + WS_WMO); bf16_t* Wfi = (bf16_t*)(ws + WS_WFI); bf16_t* Wfo = (bf16_t*)(ws + WS_WFO);
  bf16_t* H = (bf16_t*)(ws + WS_H);
  float* SS0 = (float*)(ws + WS_SS0); float* SS1 = (float*)(ws + WS_SS1); float* SSG = (float*)(ws + WS_SSG);
  LAS float* carry = (LAS float*)(lds + RING_BYTES);
  LAS float* rtab = (LAS float*)(lds + RING_BYTES + 12288);
  LAS float* wtab = (LAS float*)(lds + RING_BYTES + 13312);
  volatile LAS unsigned* bst = (volatile LAS unsigned*)(lds + LDS_BYTES - 64);
  if (threadIdx.x < 2) bst[threadIdx.x] = 0u;
  __syncthreads();
  const XcdBarrier bar = xcd_barrier_post((unsigned*)(ws + WS_BAR), bst);
#define GSYNC() xcd_barrier(bar)

  prologue_phase(P.x, H, SS0);
  zero_phase(SS1, SSG);
  { int cum = 0; convert_mixer(P, 0, Wmi, Wmo, lds, cum);
    convert_phase(P.ffn_w_in, P.ffn_norm, DM, 2 * FF, Wfi, 1, lds, cum);
    convert_phase(P.ffn_w_out, nullptr, FF, DM, Wfo, 0, lds, cum); }
  GSYNC();
  if (G == 0x7fffffff) grid.sync();

  for (int layer = 0; layer < 4; ++layer) {
    const int j = layer >> 1; const bool is_ssd = (layer & 1) == 0;
    if (layer > 0) zero_phase(SS1, nullptr);
    if (is_ssd) {
      { pg8::Gemm g{H, Wmi, 130, 25, DM, 253, -3}; pg8::StaticOrder S; S.init(130, 25, G, blockIdx.x);
        pg8::EpiSsdIn E{(bf16_t*)(ws + WS_Z), (bf16_t*)(ws + WS_XBC), (float*)(ws + WS_DT), P.ssd_conv_w + (size_t)j * 4 * SSD_CONVD, P.ssd_conv_b + (size_t)j * SSD_CONVD, P.ssd_dt_bias + j * SSD_H, {carry}, SS0, rtab, wtab};
        pg8::gemm_phase(lds, g, S, E); }
      GSYNC();
      ssd_scan_phase(P, lds, j, (bf16_t*)(ws + WS_Z), SSG);
      if (layer > 0) { int cum = 0; convert_phase(P.ffn_w_out + (size_t)layer * FF * DM, nullptr, FF, DM, Wfo, 0, lds, cum); }
      GSYNC();
      { pg8::Gemm g{(const bf16_t*)(ws + WS_Z), Wmo, 128, 4, SSD_DI, 256, 0}; pg8::StaticOrder S; S.init(128, 4, G, blockIdx.x);
        pg8::EpiRes E{H, SS1, SSG, rtab}; pg8::gemm_phase(lds, g, S, E); }
      GSYNC();
    } else {
      { pg8::Gemm g{H, Wmi, 128, 12, DM, 256, 0}; pg8::StaticOrder S; S.init(128, 12, G, blockIdx.x);
        pg8::EpiQkv E{(bf16_t*)(ws + WS_Q), (bf16_t*)(ws + WS_K), (bf16_t*)(ws + WS_VT), SS0, rtab}; pg8::gemm_phase(lds, g, S, E); }
      GSYNC();
      sb_attn_phase(P);
      { int cum = 0; convert_phase(P.ffn_w_out + (size_t)layer * FF * DM, nullptr, FF, DM, Wfo, 0, lds, cum); }
      GSYNC();
      { pg8::Gemm g{(const bf16_t*)(ws + WS_O), Wmo, 128, 4, DM, 256, 0}; pg8::StaticOrder S; S.init(128, 4, G, blockIdx.x);
        pg8::EpiRes E{H, SS1, nullptr, rtab}; pg8::gemm_phase(lds, g, S, E); }
      GSYNC();
    }
    zero_phase(SS0, SSG);
    { pg8::Gemm g{H, Wfi, 128, 22, DM, 256, 0}; pg8::StaticOrder S; S.init(128, 22, G, blockIdx.x);
      pg8::EpiFfnIn E{(bf16_t*)(ws + WS_A), P.ffn_conv_w + (size_t)layer * 3 * 2 * FF, P.ffn_conv_b + (size_t)layer * 2 * FF, {carry}, SS1, rtab, wtab, (float*)(ws + WS_PB), (float*)(ws + WS_UB)}; pg8::gemm_phase(lds, g, S, E); }
    GSYNC();
    { pg8::Gemm g{(const bf16_t*)(ws + WS_A), Wfo, 128, 4, FF, 256, 0}; pg8::StaticOrder S; S.init(128, 4, G, blockIdx.x);
      { pg8::Unit fu; for (int i = 0; S.next(i, fu); ++i) ffn_fixup_tile(fu.pm, (const float*)(ws + WS_PB), (const float*)(ws + WS_UB), P.ffn_conv_w + (size_t)layer * 3 * 2 * FF, (bf16_t*)(ws + WS_A));
        asm volatile("s_waitcnt vmcnt(0)" ::: "memory"); __syncthreads(); }
      pg8::EpiRes E{H, SS0, nullptr, rtab}; pg8::gemm_phase(lds, g, S, E); }
    if (layer < 3) {
      int cum = 0; convert_mixer(P, layer + 1, Wmi, Wmo, lds, cum);
      convert_phase(P.ffn_w_in + (size_t)(layer + 1) * DM * 2 * FF, P.ffn_norm + (layer + 1) * DM, DM, 2 * FF, Wfi, 1, lds, cum);
    }
    GSYNC();
  }
  final_norm_phase(H, P.out, P.final_norm, SS0);
}

extern "C" void kernel_launch(void* const* d_in, const int* in_sizes, int n_in, void* d_out, int out_size, void* d_ws, size_t ws_size, hipStream_t stream) {
  static int grid_blocks = 0;
  if (!grid_blocks) {
    if (n_in != 18 || out_size != T * DM || ws_size < WS_END) { fprintf(stderr, "kernel_launch: unexpected shapes (n_in %d out %d ws %zu)\n", n_in, out_size, ws_size); grid_blocks = -1; return; }
    int dev = 0, cus = 0, per_cu = 0;
    (void)hipGetDevice(&dev);
    (void)hipDeviceGetAttribute(&cus, hipDeviceAttributeMultiprocessorCount, dev);
    (void)hipFuncSetAttribute((const void*)fwd_megakernel, hipFuncAttributeMaxDynamicSharedMemorySize, LDS_BYTES);
    (void)hipOccupancyMaxActiveBlocksPerMultiprocessor(&per_cu, (const void*)fwd_megakernel, NTHREADS, LDS_BYTES);
    if (per_cu < 1) per_cu = 1;
    grid_blocks = cus * per_cu;
  }
  if (grid_blocks < 0) return;
  Params p{};
  p.x = (const float*)d_in[0]; p.mix_norm = (const float*)d_in[1]; p.ffn_norm = (const float*)d_in[2]; p.final_norm = (const float*)d_in[3];
  p.ssd_w_in = (const float*)d_in[4]; p.ssd_conv_w = (const float*)d_in[5]; p.ssd_conv_b = (const float*)d_in[6]; p.ssd_dt_bias = (const float*)d_in[7];
  p.ssd_a_log = (const float*)d_in[8]; p.ssd_d = (const float*)d_in[9]; p.ssd_norm = (const float*)d_in[10]; p.ssd_w_out = (const float*)d_in[11];
  p.sb_w_qkv = (const float*)d_in[12]; p.sb_w_out = (const float*)d_in[13]; p.ffn_w_in = (const float*)d_in[14]; p.ffn_conv_w = (const float*)d_in[15];
  p.ffn_conv_b = (const float*)d_in[16]; p.ffn_w_out = (const float*)d_in[17];
  p.out = (float*)d_out; p.ws = (unsigned char*)d_ws;
  (void)hipMemsetAsync((char*)d_ws + WS_BAR, 0, 65536, stream);
  void* args[] = {&p};
  hipError_t e = hipLaunchCooperativeKernel((const void*)fwd_megakernel, dim3(grid_blocks), dim3(NTHREADS), args, LDS_BYTES, stream);
  if (e != hipSuccess) fprintf(stderr, "cooperative launch failed: %s (grid %d)\n", hipGetErrorString(e), grid_blocks);
}
```
